# Optimizing an MI355X kernel written in HIP

```python
import math, functools
import jax, jax.numpy as jnp
from jax import lax
import numpy as np

D_MODEL = 1024
BATCH = 2
SEQ = 16384
DEPTH = 4
DEC_BATCH = 16
DEC_SEQ = 64
PAST_LEN = 2048

CHUNK = 64
QBLOCK = 128
KBLOCK = 128
MIX_WIDTH = D_MODEL
IN_WIDTH = 4 * MIX_WIDTH
DIFF_HEADS = 4
DIFF_DH = 128
SB_HEADS = 4
SB_DH = 256
KV_WIDTH = MIX_WIDTH
ROPE_THETA = 10000.0
EPS = 1e-6
NEG_INF = -1e30
N_DIFF_LAYERS = (DEPTH + 1) // 2

kernel_name = "diff_stickbreak_streaming_step"


def _rmsnorm(x, g):
    xf = x.astype(jnp.float32)
    y = xf * lax.rsqrt(jnp.mean(xf * xf, axis=-1, keepdims=True) + EPS) * g.astype(jnp.float32)
    return y.astype(x.dtype)


def _rope(x, pos):
    half = x.shape[-1] // 2
    inv = ROPE_THETA ** (-jnp.arange(half, dtype=jnp.float32) / half)
    ang = pos.astype(jnp.float32)[:, None] * inv[None, :]
    cos = jnp.cos(ang)[None, :, None, :]
    sin = jnp.sin(ang)[None, :, None, :]
    xf = x.astype(jnp.float32)
    x1, x2 = xf[..., :half], xf[..., half:]
    return jnp.concatenate([x1 * cos - x2 * sin, x2 * cos + x1 * sin], axis=-1).astype(x.dtype)


def _rev_cumsum(x):
    S = x.shape[-1]
    nkb = -(-S // KBLOCK)
    pad = nkb * KBLOCK - S
    xp = jnp.pad(x, [(0, 0)] * (x.ndim - 1) + [(0, pad)])
    xb = xp.reshape(*x.shape[:-1], nkb, KBLOCK)
    ar = jnp.arange(KBLOCK)
    tri = (ar[:, None] >= ar[None, :]).astype(x.dtype)
    within = jnp.einsum('...nj,js->...ns', xb, tri, precision=lax.Precision.HIGHEST)
    tot = jnp.sum(xb, axis=-1)
    an = jnp.arange(nkb)
    btri = (an[:, None] > an[None, :]).astype(x.dtype)
    after = jnp.einsum('...m,mn->...n', tot, btri, precision=lax.Precision.HIGHEST)
    out = (within + after[..., None]).reshape(*x.shape[:-1], nkb * KBLOCK)
    return out[..., :S]


def _attend(block_fn, q, k_all, v_all, P):
    B, T = q.shape[0], q.shape[1]
    nb = T // QBLOCK if (T % QBLOCK == 0 and T > QBLOCK) else 1
    blk = T // nb
    outs = []
    for b in range(nb):
        end = P + (b + 1) * blk
        q_pos = P + b * blk + jnp.arange(blk, dtype=jnp.int32)
        k_pos = jnp.arange(end, dtype=jnp.int32)
        outs.append(block_fn(q[:, b * blk:(b + 1) * blk], q_pos,
                             k_all[:, :end], v_all[:, :end], k_pos))
    return outs[0] if nb == 1 else jnp.concatenate(outs, axis=1)


def _diff_block(q_blk, qpos_blk, k_all, v_all, kpos, lam):
    s = jnp.einsum('bqhmd,bkhmd->bhmqk', q_blk, k_all,
                   preferred_element_type=jnp.float32) * (DIFF_DH ** -0.5)
    visible = (kpos // CHUNK)[None, :] <= (qpos_blk // CHUNK)[:, None]
    s = jnp.where(visible, s, NEG_INF)
    p = jax.nn.softmax(s, axis=-1)
    w = p[:, :, 0] - lam * p[:, :, 1]
    return jnp.einsum('bhqk,bkhe->bqhe', w.astype(v_all.dtype), v_all)


def _sb_block(q_blk, qpos_blk, k_all, v_all, kpos):
    z = jnp.einsum('bqhd,bkhd->bhqk', q_blk, k_all,
                   preferred_element_type=jnp.float32) * (SB_DH ** -0.5)
    earlier = kpos[None, :] < qpos_blk[:, None]
    log_keep = jnp.where(earlier, jax.nn.log_sigmoid(-z), 0.0)
    a = jnp.where(earlier, jnp.exp(z + _rev_cumsum(log_keep)), 0.0)
    return jnp.einsum('bhqk,bkhd->bqhd', a.astype(v_all.dtype), v_all)


def _diff_mixer(h, past_k, past_v, w_in_l, w_out_l, lam_vecs, subln_w, lam_init):
    B, T, _ = h.shape
    P = 0 if past_k is None else past_k.shape[1]
    q_pos = P + jnp.arange(T, dtype=jnp.int32)
    q, k, v, g = jnp.split(h @ w_in_l, 4, axis=-1)
    q = _rope(q.reshape(B, T, 2 * DIFF_HEADS, DIFF_DH), q_pos).reshape(B, T, DIFF_HEADS, 2, DIFF_DH)
    k_rows = _rope(k.reshape(B, T, 2 * DIFF_HEADS, DIFF_DH), q_pos).reshape(B, T, KV_WIDTH)
    v_rows = v
    if past_k is None:
        k_all, v_all = k_rows, v_rows
    else:
        k_all = jnp.concatenate([past_k, k_rows], axis=1)
        v_all = jnp.concatenate([past_v, v_rows], axis=1)
    lf = lam_vecs.astype(jnp.float32)
    lam = jnp.exp(jnp.sum(lf[0] * lf[1])) - jnp.exp(jnp.sum(lf[2] * lf[3])) + lam_init
    block = functools.partial(_diff_block, lam=lam)
    o = _attend(block, q,
                k_all.reshape(B, P + T, DIFF_HEADS, 2, DIFF_DH),
                v_all.reshape(B, P + T, DIFF_HEADS, 2 * DIFF_DH), P)
    o = _rmsnorm(o, subln_w) * (1.0 - lam_init)
    o = o.reshape(B, T, MIX_WIDTH) * jax.nn.silu(g)
    return o @ w_out_l, k_rows, v_rows


def _sb_mixer(h, past_k, past_v, w_in_l, w_out_l):
    B, T, _ = h.shape
    P = 0 if past_k is None else past_k.shape[1]
    q, k_rows, v_rows, g = jnp.split(h @ w_in_l, 4, axis=-1)
    if past_k is None:
        k_all, v_all = k_rows, v_rows
    else:
        k_all = jnp.concatenate([past_k, k_rows], axis=1)
        v_all = jnp.concatenate([past_v, v_rows], axis=1)
    o = _attend(_sb_block, q.reshape(B, T, SB_HEADS, SB_DH),
                k_all.reshape(B, P + T, SB_HEADS, SB_DH),
                v_all.reshape(B, P + T, SB_HEADS, SB_DH), P)
    o = o.reshape(B, T, MIX_WIDTH) * jax.nn.silu(g)
    return o @ w_out_l, k_rows, v_rows


def setup_inputs(seed: int = 0) -> dict:
    key = jax.random.key(seed)
    ks = jax.random.split(key, 10)
    f32 = jnp.float32
    x_prompt = jax.random.normal(ks[0], (BATCH, SEQ, D_MODEL), f32)
    x_sample = jax.random.normal(ks[1], (DEC_BATCH, DEC_SEQ, D_MODEL), f32)
    cache_k = jax.random.normal(ks[2], (DEPTH, DEC_BATCH, PAST_LEN, KV_WIDTH), f32)
    cache_v = jax.random.normal(ks[3], (DEPTH, DEC_BATCH, PAST_LEN, KV_WIDTH), f32)
    norm_w = 1.0 + 0.01 * jax.random.normal(ks[4], (DEPTH, D_MODEL), f32)
    w_in = jax.random.normal(ks[5], (DEPTH, D_MODEL, IN_WIDTH), f32) * (D_MODEL ** -0.5)
    w_out = jax.random.normal(ks[6], (DEPTH, MIX_WIDTH, D_MODEL), f32) * (MIX_WIDTH ** -0.5)
    diff_lambda = 0.1 * jax.random.normal(ks[7], (N_DIFF_LAYERS, 4, DIFF_DH), f32)
    diff_subln_w = 1.0 + 0.01 * jax.random.normal(ks[8], (N_DIFF_LAYERS, 2 * DIFF_DH), f32)
    final_norm_w = 1.0 + 0.01 * jax.random.normal(ks[9], (D_MODEL,), f32)
    return {"x_prompt": x_prompt, "x_sample": x_sample, "cache_k": cache_k, "cache_v": cache_v,
            "norm_w": norm_w, "w_in": w_in, "w_out": w_out, "diff_lambda": diff_lambda,
            "diff_subln_w": diff_subln_w, "final_norm_w": final_norm_w}


def reference(x_prompt, x_sample, cache_k, cache_v, norm_w, w_in, w_out, diff_lambda,
              diff_subln_w, final_norm_w):
    yp, ys = x_prompt, x_sample
    kp_list, vp_list, ks_list, vs_list = [], [], [], []
    for i in range(DEPTH):
        hp = _rmsnorm(yp, norm_w[i])
        hs = _rmsnorm(ys, norm_w[i])
        if i % 2 == 0:
            j = i // 2
            lam_init = 0.8 - 0.6 * math.exp(-0.3 * i)
            mix = functools.partial(_diff_mixer, w_in_l=w_in[i], w_out_l=w_out[i],
                                    lam_vecs=diff_lambda[j], subln_w=diff_subln_w[j],
                                    lam_init=lam_init)
        else:
            mix = functools.partial(_sb_mixer, w_in_l=w_in[i], w_out_l=w_out[i])
        op, kp, vp = mix(hp, None, None)
        os_, ks_, vs_ = mix(hs, cache_k[i], cache_v[i])
        yp = yp + op
        ys = ys + os_
        kp_list.append(kp)
        vp_list.append(vp)
        ks_list.append(ks_)
        vs_list.append(vs_)
    y_prompt = _rmsnorm(yp, final_norm_w)
    y_sample = _rmsnorm(ys, final_norm_w)
    new_k_prompt = jnp.stack(kp_list, axis=0)
    new_v_prompt = jnp.stack(vp_list, axis=0)
    new_k_sample = jnp.stack(ks_list, axis=0)
    new_v_sample = jnp.stack(vs_list, axis=0)
    return (y_prompt, y_sample, new_k_prompt, new_v_prompt, new_k_sample, new_v_sample)
```

```cpp
#include <hip/hip_runtime.h>
#include <cstdio>
#include <cstdint>

#ifndef MK_PER_PHASE
#define MK_PER_PHASE 0
#endif

constexpr int D = 1024, NBATCH = 2, SEQ = 16384, DEPTH = 4, DBATCH = 16, DSEQ = 64, PAST = 2048;
constexpr int MP = NBATCH * SEQ, MS = DBATCH * DSEQ, MTOT = MP + MS;
constexpr int NIN = 4 * D;
constexpr float EPS = 1e-6f;
constexpr size_t OY_P = 0, OY_S = OY_P + (size_t)MP * D, OK_P = OY_S + (size_t)MS * D, OV_P = OK_P + (size_t)DEPTH * MP * D,
                 OK_S = OV_P + (size_t)DEPTH * MP * D, OV_S = OK_S + (size_t)DEPTH * MS * D, O_END = OV_S + (size_t)DEPTH * MS * D;
constexpr size_t WS_CTL = 0, CTL_BYTES = 65536;
constexpr size_t WS_WIN = WS_CTL + CTL_BYTES;
constexpr size_t WS_WOUT = WS_WIN + (size_t)DEPTH * NIN * D * 2;
constexpr size_t WS_COS = WS_WOUT + (size_t)DEPTH * D * D * 2;
constexpr size_t WS_SIN = WS_COS + (size_t)SEQ * 64 * 4;
constexpr size_t WS_H = WS_SIN + (size_t)SEQ * 64 * 4;
constexpr size_t WS_QKVG = WS_H + (size_t)MTOT * D * 2;
constexpr size_t WS_Y = WS_QKVG + (size_t)MTOT * NIN * 2;
constexpr size_t WS_CK = WS_Y + (size_t)MTOT * D * 4;
constexpr size_t WS_CV = WS_CK + (size_t)DEPTH * DBATCH * PAST * D * 2;
constexpr size_t WS_END = WS_CV + (size_t)DEPTH * DBATCH * PAST * D * 2;
constexpr int CW_BAR = 0;
constexpr int CW_KM = 4096;
constexpr int CW_TMO = 4096 + 256;

typedef unsigned short bf16_t;
typedef short bf16x8 __attribute__((ext_vector_type(8)));
typedef short s16x4 __attribute__((ext_vector_type(4)));
typedef float f32x16 __attribute__((ext_vector_type(16)));
typedef float f32x4 __attribute__((ext_vector_type(4)));
typedef float f32x2 __attribute__((ext_vector_type(2)));
typedef unsigned u32x4 __attribute__((ext_vector_type(4)));
typedef unsigned u32x2 __attribute__((ext_vector_type(2)));
#define LAS __attribute__((address_space(3)))
#define GAS __attribute__((address_space(1)))
template <class T> __device__ __forceinline__ T* as_global(T* p) { return (T*)(GAS T*)p; }

__device__ __forceinline__ unsigned cvtpk(float lo, float hi) { unsigned r; asm volatile("v_cvt_pk_bf16_f32 %0, %1, %2" : "=v"(r) : "v"(lo), "v"(hi)); return r; }
__device__ __forceinline__ float bf_lo(unsigned w) { return __uint_as_float(w << 16); }
__device__ __forceinline__ float bf_hi(unsigned w) { return __uint_as_float(w & 0xffff0000u); }
__device__ __forceinline__ float bf2f(bf16_t b) { return __uint_as_float(((unsigned)b) << 16); }
__device__ __forceinline__ float wave_sum(float v) { for (int o = 32; o >= 1; o >>= 1) v += __shfl_xor(v, o); return v; }
__device__ __forceinline__ float wave_max(float v) { for (int o = 32; o >= 1; o >>= 1) v = fmaxf(v, __shfl_xor(v, o)); return v; }

#define XB_TMO      128
#define XB_XCNT(j)  (256  + 64 * (j))
#define XB_XSUB(j)  (1280 + 64 * (j))
#define XB_XGEN(j)  (2304 + 64 * (j))
#define XB_TOP      3328
#define XB_TOPGEN   3392
#define XCD_BAR_WORDS 3456
#define XB_SPIN_CAP (1u << 22)
__device__ __forceinline__ unsigned xb_ld(unsigned* p)              { return __hip_atomic_load(p, __ATOMIC_RELAXED, __HIP_MEMORY_SCOPE_AGENT); }
__device__ __forceinline__ unsigned xb_add(unsigned* p, unsigned v) { return __hip_atomic_fetch_add(p, v, __ATOMIC_RELAXED, __HIP_MEMORY_SCOPE_AGENT); }
__device__ __forceinline__ unsigned xb_xcc_id() { return (unsigned)__builtin_amdgcn_s_getreg((3 << 11) | 20) & 0xFu; }
#define XB_SPIN(cond, bar) do { unsigned _sp = 0; while (cond) { __builtin_amdgcn_s_sleep(1); \
    if ((++_sp & 255u) == 0u) { if (xb_ld(&(bar)[XB_TMO])) break; if (_sp > XB_SPIN_CAP) { atomicAdd(&(bar)[XB_TMO], 1u); break; } } } } while (0)
struct XcdBarrier { unsigned* bar; unsigned x; volatile LAS unsigned* st; };
__device__ __forceinline__ XcdBarrier xcd_barrier_post(unsigned* bar, volatile LAS unsigned* st) {
    XcdBarrier b; b.bar = bar; b.x = xb_xcc_id(); b.st = st;
    if (threadIdx.x == 0) (void)xb_add(&bar[XB_XCNT(b.x)], 1u);
    return b;
}
__device__ __forceinline__ void xcd_barrier_complete(unsigned* bar, unsigned x, unsigned& nloc, unsigned& nx) {
    const unsigned G = gridDim.x * gridDim.y * gridDim.z;
    unsigned sum, cnt, mine, sp = 0u;
    for (;;) {
        sum = 0u; cnt = 0u; mine = 0u;
#pragma unroll
        for (unsigned j = 0; j < 16; ++j) { const unsigned c = xb_ld(&bar[XB_XCNT(j)]); sum += c; cnt += (c > 0u) ? 1u : 0u; mine = (j == x) ? c : mine; }
        if (sum == G) break;
        __builtin_amdgcn_s_sleep(1);
        if ((++sp & 255u) == 0u) { if (xb_ld(&bar[XB_TMO])) break; if (sp > XB_SPIN_CAP) { atomicAdd(&bar[XB_TMO], 1u); break; } }
    }
    nloc = mine > 0u ? mine : 1u; nx = cnt > 0u ? cnt : 1u;
}
__device__ __forceinline__ void xcd_barrier(const XcdBarrier& b) {
    asm volatile("s_waitcnt vmcnt(0)" ::: "memory");
    __syncthreads();
    if (threadIdx.x == 0) {
        unsigned* bar = b.bar;
        __builtin_amdgcn_s_waitcnt(0);
        unsigned nloc = b.st[0], nx = b.st[1];
        if (nloc == 0u) { xcd_barrier_complete(bar, b.x, nloc, nx); b.st[0] = nloc; b.st[1] = nx; }
        const unsigned old = xb_add(&bar[XB_XSUB(b.x)], 1u);
        const unsigned gen = old / nloc;
        if (old + 1u == (gen + 1u) * nloc) {
            __builtin_amdgcn_fence(__ATOMIC_RELEASE, "agent");
            asm volatile("s_waitcnt vmcnt(0)" ::: "memory");
            const unsigned og = xb_add(&bar[XB_TOP], 1u);
            const unsigned tg = og / nx;
            if (og + 1u == (tg + 1u) * nx) xb_add(&bar[XB_TOPGEN], 1u);
            else XB_SPIN(xb_ld(&bar[XB_TOPGEN]) == tg, bar);
            __builtin_amdgcn_fence(__ATOMIC_ACQUIRE, "agent");
            xb_add(&bar[XB_XGEN(b.x)], 1u);
            asm volatile("s_waitcnt vmcnt(0)" ::: "memory");
        } else {
            XB_SPIN(xb_ld(&bar[XB_XGEN(b.x)]) == gen, bar);
            __builtin_amdgcn_fence(__ATOMIC_ACQUIRE, "agent");
            asm volatile("s_waitcnt vmcnt(0)" ::: "memory");
        }
    }
    __syncthreads();
}

namespace pg8 {
constexpr int BM = 256, BK = 64, HALF = 128, HTB = HALF * BK * 2, STAGE_BYTES = 8 * HTB, NXCD = 8, WGM = 8;
__host__ __device__ __forceinline__ int lds_byte(int r, int c) { const int st = (r >> 4) * 2 + (c >> 5), rr = r & 15, cc = c & 31, ob = rr * 64 + cc * 2; return st * 1024 + (ob ^ (((ob >> 9) & 1) << 5)); }
__host__ __device__ __forceinline__ void stage_rc(int b, int& R, int& C) { const int st = b / 1024, sb = b % 1024, swz = sb ^ (((sb >> 9) & 1) << 5); R = (st >> 1) * 16 + swz / 64; C = (st & 1) * 32 + (swz % 64) / 2; }
__host__ __device__ __forceinline__ int perm32(int rho) { const int n = rho >> 4, i = rho & 15; return 8 * (i >> 2) + 4 * n + (i & 3); }
struct Unit { int pm, pn; };
struct Gemm { const bf16_t* A; const bf16_t* Bt; int M, N, K; };
struct StaticOrder {
    int nM, nN, nwg, G, c;
    __host__ __device__ void init(int M, int N, int G_, int c_) { nM = M / BM; nN = N / BM; nwg = nM * nN; G = G_; c = c_; }
    __host__ __device__ bool next(int i, Unit& u) const {
        const long L = (long)i * G + c; if (L >= nwg) return false;
        int wgid = (int)L; { const int q = nwg / NXCD, r = nwg % NXCD, xcd = wgid % NXCD, off = wgid / NXCD; wgid = (xcd < r ? xcd * (q + 1) : r * (q + 1) + (xcd - r) * q) + off; }
        const int nig = WGM * nN, gid = wgid / nig, fm = gid * WGM, gsz = (nM - fm) < WGM ? (nM - fm) : WGM;
        u.pm = fm + ((wgid % nig) % gsz); u.pn = (wgid % nig) / gsz; return true;
    }
};

template <class Epi>
__device__ __forceinline__ void gemm_phase(LAS unsigned char* lds, const Gemm g, const StaticOrder& S, const Epi& E) {
    int tid = threadIdx.x; asm volatile("" : "+v"(tid));
    const int wid = __builtin_amdgcn_readfirstlane(tid >> 6), lane = tid & 63, wr = wid >> 2, wc = wid & 3, fr = lane & 15, fq = lane >> 4;
    const int K = g.K, nt = K / BK;
    unsigned voffA[2], voffB[2];
#pragma unroll
    for (int i = 0; i < 2; ++i) { int R, C; stage_rc(tid * 16 + i * 8192, R, C); const int Rb = Epi::brow(R);
        voffA[i] = (unsigned)(R * K + C) * 2u; voffB[i] = (unsigned)(Rb * K + C) * 2u; }
    const size_t kstep = (size_t)(BK * 2);
    const size_t hstep = (size_t)HALF * K * 2;
    const size_t hstepB = (size_t)Epi::BHROWS * K * 2;
    const size_t tstep = 2 * hstep;
    const unsigned ldsw = (unsigned)wid * 1024u;
    const int aoff = lds_byte(wr * 64 + fr, fq * 8), boff = lds_byte(wc * 32 + fr, fq * 8);
#define PG8_SA(b, h) (((b) * 2 + (h)) * HTB)
#define PG8_SB(b, h) ((4 + (b) * 2 + (h)) * HTB)
#define PG8_STAGE(bufoff, gbase, voff) do { _Pragma("unroll") for (int _i = 0; _i < 2; ++_i) \
        __builtin_amdgcn_global_load_lds((const unsigned*)((const char*)(gbase) + (voff)[_i]), (LAS unsigned*)(lds + (bufoff) + ldsw + _i * 8192), 16, 0, 0); } while (0)
#define PG8_LDA(dst, b, h) do { _Pragma("unroll") for (int m = 0; m < 4; ++m) _Pragma("unroll") for (int k = 0; k < 2; ++k) dst[m][k] = *(const LAS bf16x8*)(lds + PG8_SA(b, h) + aoff + m * 2048 + k * 1024); } while (0)
#define PG8_LDB(dst, b, h) do { _Pragma("unroll") for (int n = 0; n < 2; ++n) _Pragma("unroll") for (int k = 0; k < 2; ++k) dst[n][k] = *(const LAS bf16x8*)(lds + PG8_SB(b, h) + boff + n * 2048 + k * 1024); } while (0)
#define PG8_MMA(ai, bj, At, Bt) do { __builtin_amdgcn_s_setprio(1); _Pragma("unroll") for (int m = 0; m < 4; ++m) _Pragma("unroll") for (int n = 0; n < 2; ++n) _Pragma("unroll") for (int k = 0; k < 2; ++k) \
        acc[ai][bj][m][n] = __builtin_amdgcn_mfma_f32_16x16x32_bf16(Bt[n][k], At[m][k], acc[ai][bj][m][n], 0, 0, 0); __builtin_amdgcn_s_setprio(0); } while (0)
#define PG8_WAIT_V(n) asm volatile("s_waitcnt vmcnt(" #n ")" ::: "memory")
#define PG8_WAIT_L(n) asm volatile("s_waitcnt lgkmcnt(" #n ")" ::: "memory")
#define PG8_BAR __builtin_amdgcn_s_barrier()
#define PG8_SCHED __builtin_amdgcn_sched_barrier(0)
    Unit cur, nxt; int ui = 0;
    if (!S.next(0, cur)) return;
    f32x4 acc[2][2][4][2];
#pragma unroll
    for (int a = 0; a < 2; ++a)
#pragma unroll
        for (int b = 0; b < 2; ++b)
#pragma unroll
            for (int m = 0; m < 4; ++m)
#pragma unroll
                for (int n = 0; n < 2; ++n) acc[a][b][m][n] = (f32x4){0.f, 0.f, 0.f, 0.f};
    bf16x8 At[4][2], B0[2][2], B1[2][2];
    const char* cA = (const char*)g.A + (size_t)cur.pm * tstep; const char* cB = (const char*)g.Bt + (size_t)cur.pn * tstep;
    PG8_STAGE(PG8_SB(0, 0), cB, voffB); PG8_STAGE(PG8_SA(0, 0), cA, voffA); PG8_STAGE(PG8_SB(0, 1), cB + hstepB, voffB); PG8_STAGE(PG8_SA(0, 1), cA + hstep, voffA);
    if (wr == 1) PG8_BAR;
    PG8_WAIT_V(4); PG8_BAR;
    PG8_STAGE(PG8_SB(1, 0), cB + kstep, voffB); PG8_STAGE(PG8_SA(1, 0), cA + kstep, voffA); PG8_STAGE(PG8_SB(1, 1), cB + hstepB + kstep, voffB);
    PG8_WAIT_V(6); PG8_BAR;
    for (;;) {
        const bool has_next = S.next(ui + 1, nxt);
        const char* nA = has_next ? (const char*)g.A + (size_t)nxt.pm * tstep : cA; const char* nB = has_next ? (const char*)g.Bt + (size_t)nxt.pn * tstep : cB;
        for (int t = 0; t < nt; t += 2) {
            const bool last = (t == nt - 2);
            const char* a1 = cA + (size_t)(t + 1) * kstep;
            const char* a2 = last ? nA : cA + (size_t)(t + 2) * kstep; const char* b2 = last ? nB : cB + (size_t)(t + 2) * kstep;
            const char* a3 = a2 + kstep; const char* b3 = b2 + kstep;
            PG8_LDB(B0, 0, 0); PG8_SCHED; PG8_LDA(At, 0, 0); PG8_STAGE(PG8_SA(1, 1), a1 + hstep, voffA);
            PG8_WAIT_L(8); PG8_BAR; PG8_WAIT_L(0); PG8_MMA(0, 0, At, B0); PG8_BAR; PG8_SCHED;
            PG8_LDB(B1, 0, 1); PG8_STAGE(PG8_SB(0, 0), b2, voffB);
            PG8_BAR; PG8_WAIT_L(0); PG8_MMA(0, 1, At, B1); PG8_BAR;
            PG8_LDA(At, 0, 1); PG8_STAGE(PG8_SA(0, 0), a2, voffA);
            PG8_BAR; PG8_WAIT_L(0); PG8_MMA(1, 0, At, B0); PG8_BAR; PG8_SCHED;
            PG8_STAGE(PG8_SB(0, 1), b2 + hstepB, voffB);
            PG8_WAIT_V(6); PG8_BAR; PG8_MMA(1, 1, At, B1); PG8_BAR;
            PG8_LDB(B0, 1, 0); PG8_SCHED; PG8_LDA(At, 1, 0); PG8_STAGE(PG8_SA(0, 1), a2 + hstep, voffA);
            PG8_WAIT_L(8); PG8_BAR; PG8_WAIT_L(0); PG8_MMA(0, 0, At, B0); PG8_BAR; PG8_SCHED;
            PG8_LDB(B1, 1, 1); PG8_STAGE(PG8_SB(1, 0), b3, voffB);
            PG8_BAR; PG8_WAIT_L(0); PG8_MMA(0, 1, At, B1); PG8_BAR;
            PG8_LDA(At, 1, 1); PG8_STAGE(PG8_SA(1, 0), a3, voffA);
            PG8_BAR; PG8_WAIT_L(0); PG8_MMA(1, 0, At, B0); PG8_BAR; PG8_SCHED;
            PG8_STAGE(PG8_SB(1, 1), b3 + hstepB, voffB);
            PG8_WAIT_V(6); PG8_BAR; PG8_MMA(1, 1, At, B1); PG8_BAR;
        }
        E(acc, cur, wr, wc, fr, fq);
        if (!has_next) break;
#pragma unroll
        for (int a = 0; a < 2; ++a)
#pragma unroll
            for (int b = 0; b < 2; ++b)
#pragma unroll
                for (int m = 0; m < 4; ++m)
#pragma unroll
                    for (int n = 0; n < 2; ++n) acc[a][b][m][n] = (f32x4){0.f, 0.f, 0.f, 0.f};
        cur = nxt; cA = nA; cB = nB; ++ui;
    }
    PG8_WAIT_V(0);
    if (wr == 0) PG8_BAR;
    PG8_BAR;
#undef PG8_SA
#undef PG8_SB
#undef PG8_STAGE
#undef PG8_LDA
#undef PG8_LDB
#undef PG8_MMA
#undef PG8_WAIT_V
#undef PG8_WAIT_L
#undef PG8_BAR
#undef PG8_SCHED
}
}

struct EpiIn {
    static constexpr int BHROWS = 64;
    __host__ __device__ static __forceinline__ int brow(int R) { const int wc = R >> 5; return 128 * (wc >> 1) + 32 * (wc & 1) + pg8::perm32(R & 31); }
    bf16_t* qkvg; float* out; const float* cosT; int l;
    __device__ __forceinline__ void operator()(const f32x4 (&acc)[2][2][4][2], const pg8::Unit& u, int wr, int wc, int fr, int fq) const {
        float* ob = out; asm volatile("" : "+s"(ob)); ob = as_global(ob);
        const int rope = (l & 1) ^ 1;
        float* outk_p = ob + OK_P + (size_t)l * MP * D; float* outv_p = ob + OV_P + (size_t)l * MP * D;
        float* outk_s = ob + OK_S + (size_t)l * MS * D; float* outv_s = ob + OV_S + (size_t)l * MS * D;
        const float* sinT = cosT + (size_t)SEQ * 64;
        const int sec = u.pn >> 2, ct = (u.pn & 3) * 256 + 128 * (wc >> 1) + 32 * (wc & 1) + 8 * fq;
        const int row0 = u.pm * 256 + wr * 64 + fr;
        const bool prompt = u.pm < (MP / 256);
        const bool dof = (sec == 1) || (sec == 2);
        float* fo = (sec == 1) ? (prompt ? outk_p : outk_s - (size_t)MP * D) : (prompt ? outv_p : outv_s - (size_t)MP * D);
        const bool dorope = rope && sec < 2;
        const float qs = (!rope && sec == 0) ? 0.0625f : 1.0f;
        const int dcol = 32 * (wc & 1) + 8 * fq;
#pragma unroll
        for (int ai = 0; ai < 2; ++ai)
#pragma unroll
            for (int m = 0; m < 4; ++m) {
                const int row = row0 + ai * 128 + m * 16;
                f32x4 v[2][2];
#pragma unroll
                for (int bj = 0; bj < 2; ++bj)
#pragma unroll
                    for (int n = 0; n < 2; ++n) v[bj][n] = acc[ai][bj][m][n] * qs;
                if (dorope) {
                    const int pos = prompt ? (row & (SEQ - 1)) : PAST + ((row - MP) & (DSEQ - 1));
#pragma unroll
                    for (int n = 0; n < 2; ++n) {
                        const f32x4 c = *(const f32x4*)(cosT + (size_t)pos * 64 + dcol + 4 * n), s = *(const f32x4*)(sinT + (size_t)pos * 64 + dcol + 4 * n);
                        const f32x4 x1 = v[0][n], x2 = v[1][n];
                        v[0][n] = x1 * c - x2 * s; v[1][n] = x2 * c + x1 * s;
                    }
                }
                bf16_t* qp = qkvg + (size_t)row * NIN + sec * 1024 + ct;
#pragma unroll
                for (int bj = 0; bj < 2; ++bj) {
                    u32x4 w; w.x = cvtpk(v[bj][0][0], v[bj][0][1]); w.y = cvtpk(v[bj][0][2], v[bj][0][3]); w.z = cvtpk(v[bj][1][0], v[bj][1][1]); w.w = cvtpk(v[bj][1][2], v[bj][1][3]);
                    *(u32x4*)(qp + bj * 64) = w;
                }
                if (dof) {
                    GAS float* fp = (GAS float*)(fo + (size_t)row * D + ct);
#pragma unroll
                    for (int bj = 0; bj < 2; ++bj) { *(GAS f32x4*)(fp + bj * 64) = v[bj][0]; *(GAS f32x4*)(fp + bj * 64 + 4) = v[bj][1]; }
                }
            }
    }
};
struct EpiOut {
    static constexpr int BHROWS = 128;
    __host__ __device__ static __forceinline__ int brow(int R) { return R; }
    const float* yin_p; const float* yin_s; float* yout;
    __device__ __forceinline__ void operator()(const f32x4 (&acc)[2][2][4][2], const pg8::Unit& u, int wr, int wc, int fr, int fq) const {
        const int row0 = u.pm * 256 + wr * 64 + fr, col0 = u.pn * 256 + wc * 32 + 4 * fq;
        const float* yi = (u.pm < (MP / 256)) ? yin_p : yin_s;
#pragma unroll
        for (int ai = 0; ai < 2; ++ai)
#pragma unroll
            for (int m = 0; m < 4; ++m) { const size_t ro = (size_t)(row0 + ai * 128 + m * 16) * D + col0;
#pragma unroll
                for (int bj = 0; bj < 2; ++bj)
#pragma unroll
                    for (int n = 0; n < 2; ++n) *(f32x4*)(yout + ro + bj * 128 + n * 16) = *(const f32x4*)(yi + ro + bj * 128 + n * 16) + acc[ai][bj][m][n]; }
    }
};

constexpr int NW = 8, NTHR = 512;
constexpr int LDS_MAIN = 131072, LDS_SCR = LDS_MAIN, LDS_SCR_BYTES = 8 * 512, LDS_MISC = LDS_SCR + LDS_SCR_BYTES, LDS_BYTES = LDS_MISC + 256;

__device__ __forceinline__ int ltid() { int t = threadIdx.x; asm volatile("" : "+v"(t)); return t; }
__device__ __forceinline__ void norm_phase(const float* xp, const float* xs  , const float* g, bf16_t* hb, float* op, float* os  , int mode) {
    const int tid = ltid(), lane = tid & 63, wid = tid >> 6;
    f32x4 gw[4];
#pragma unroll
    for (int i = 0; i < 2; ++i) { gw[2 * i] = *(const f32x4*)(g + i * 512 + lane * 8); gw[2 * i + 1] = *(const f32x4*)(g + i * 512 + lane * 8 + 4); }
    for (int row = blockIdx.x * NW + wid; row < MTOT; row += gridDim.x * NW) {
        const float* x = (row < MP ? xp : xs) + (size_t)row * D;
        f32x4 v[4];
#pragma unroll
        for (int i = 0; i < 2; ++i) { v[2 * i] = *(const f32x4*)(x + i * 512 + lane * 8); v[2 * i + 1] = *(const f32x4*)(x + i * 512 + lane * 8 + 4); }
        float s = 0.f;
#pragma unroll
        for (int i = 0; i < 4; ++i) s += v[i][0] * v[i][0] + v[i][1] * v[i][1] + v[i][2] * v[i][2] + v[i][3] * v[i][3];
        s = wave_sum(s);
        const float r = 1.0f / sqrtf(s * (1.0f / D) + EPS);
#pragma unroll
        for (int i = 0; i < 4; ++i) v[i] = v[i] * r * gw[i];
        if (mode == 0) {
#pragma unroll
            for (int i = 0; i < 2; ++i) { u32x4 w; w.x = cvtpk(v[2 * i][0], v[2 * i][1]); w.y = cvtpk(v[2 * i][2], v[2 * i][3]); w.z = cvtpk(v[2 * i + 1][0], v[2 * i + 1][1]); w.w = cvtpk(v[2 * i + 1][2], v[2 * i + 1][3]);
                *(u32x4*)(hb + (size_t)row * D + i * 512 + lane * 8) = w; }
        } else {
            float* o = (row < MP ? op : os) + (size_t)row * D;
#pragma unroll
            for (int i = 0; i < 2; ++i) { *(f32x4*)(o + i * 512 + lane * 8) = v[2 * i]; *(f32x4*)(o + i * 512 + lane * 8 + 4) = v[2 * i + 1]; }
        }
    }
}
__device__ __forceinline__ void transpose_weights(const float* W, bf16_t* Wt, int N, int nmat, LAS float* sm) {
    const int tid = ltid();
    const int tilesN = N / 64, tilesK = D / 128, per = tilesN * tilesK, total = per * nmat;
    for (int t = blockIdx.x; t < total; t += gridDim.x) {
        const int mat = t / per, tt = t % per, tk = tt / tilesN, tn = tt % tilesN;
        const float* src = W + (size_t)mat * D * N + (size_t)(tk * 128) * N + tn * 64;
        __syncthreads();
#pragma unroll
        for (int p = 0; p < 4; ++p) { const int r = p * 32 + (tid >> 4), c = (tid & 15) * 4; *(LAS f32x4*)(sm + r * 68 + c) = *(const f32x4*)(src + (size_t)r * N + c); }
        __syncthreads();
        const int n = tid & 63, kc = tid >> 6;
        unsigned w[8];
#pragma unroll
        for (int i = 0; i < 8; ++i) w[i] = cvtpk(sm[(kc * 16 + 2 * i) * 68 + n], sm[(kc * 16 + 2 * i + 1) * 68 + n]);
        bf16_t* dst = Wt + (size_t)mat * N * D + (size_t)(tn * 64 + n) * D + tk * 128 + kc * 16;
        *(u32x4*)dst = (u32x4){w[0], w[1], w[2], w[3]}; *(u32x4*)(dst + 8) = (u32x4){w[4], w[5], w[6], w[7]};
    }
    __syncthreads();
}
__device__ __forceinline__ void convert_bf16(const float* src, bf16_t* dst, size_t n) {
    const size_t stride = (size_t)gridDim.x * NTHR * 8;
    const int tid = ltid();
    for (size_t i = ((size_t)blockIdx.x * NTHR + tid) * 8; i < n; i += stride) {
        const f32x4 a = __builtin_nontemporal_load((const f32x4*)(src + i)), b = __builtin_nontemporal_load((const f32x4*)(src + i + 4));
        u32x4 w; w.x = cvtpk(a[0], a[1]); w.y = cvtpk(a[2], a[3]); w.z = cvtpk(b[0], b[1]); w.w = cvtpk(b[2], b[3]);
        *(u32x4*)(dst + i) = w;
    }
}
__device__ __forceinline__ void rope_table(float* cosT, float* sinT) {
    const int tid = ltid();
    for (int i = blockIdx.x * NTHR + tid; i < SEQ * 64; i += gridDim.x * NTHR) {
        const int pos = i >> 6, d = i & 63;
        const float inv = (float)pow(10000.0, -(double)d / 64.0);
        const float ang = (float)pos * inv;
        cosT[i] = (float)cos((double)ang); sinT[i] = (float)sin((double)ang);
    }
}


namespace att {
constexpr int KBUF = 32768, VBUF = 32768, LV0 = 65536;
__device__ __forceinline__ int swap23(int k) { return (k & ~0xC) | ((k & 4) << 1) | ((k & 8) >> 1); }
__device__ __forceinline__ int v_rd_base(int lane) { return ((lane & 3) << 3) | (((lane >> 2) & 3) << 6) | (((lane >> 4) & 1) << 5) | (((lane >> 5) & 1) << 8); }
constexpr int v_rd_off(int d0, int ks, int half) { return d0 * 512 + ks * 8192 + half * 4096; }
__device__ __forceinline__ int crow(int r, int hi) { return (r & 3) + 8 * (r >> 2) + 4 * hi; }
#define SBAR() __builtin_amdgcn_sched_barrier(0)
#define WGBAR() do { asm volatile("" ::: "memory"); __builtin_amdgcn_s_barrier(); asm volatile("" ::: "memory"); } while (0)
#define GLDS(gp, lp) __builtin_amdgcn_global_load_lds((const unsigned*)(gp), (LAS unsigned*)(lp), 16, 0, 0)
#define PK4(P, B_, OUT) do { unsigned a0 = cvtpk(P[B_+0], P[B_+1]), a1 = cvtpk(P[B_+2], P[B_+3]);                          \
        unsigned b0 = cvtpk(P[B_+4], P[B_+5]), b1 = cvtpk(P[B_+6], P[B_+7]);                                             \
        auto r0 = __builtin_amdgcn_permlane32_swap(a0, b0, false, false); auto r1 = __builtin_amdgcn_permlane32_swap(a1, b1, false, false); \
        u32x4 w = {r0[0], r1[0], r0[1], r1[1]}; OUT = *reinterpret_cast<bf16x8*>(&w); } while (0)
#define TRRD(dst, addr, off) asm volatile("ds_read_b64_tr_b16 %0, %1 offset:%2" : "=&v"(dst) : "v"(addr), "i"(off) : "memory")
#define PV_D0(o_, vb, d0) do { s16x4 l0, l1, l2, l3, h0, h1, h2, h3; constexpr int b_ = v_rd_off(d0, 0, 0);   \
        TRRD(l0, vb, b_); TRRD(h0, vb, b_ + 4096); TRRD(l1, vb, b_ + 8192); TRRD(h1, vb, b_ + 12288); TRRD(l2, vb, b_ + 16384); TRRD(h2, vb, b_ + 20480); TRRD(l3, vb, b_ + 24576); TRRD(h3, vb, b_ + 28672); \
        asm volatile("s_waitcnt lgkmcnt(0)" ::: "memory"); SBAR();             \
        o_ = __builtin_amdgcn_mfma_f32_32x32x16_bf16(pa0, (bf16x8){l0[0], l0[1], l0[2], l0[3], h0[0], h0[1], h0[2], h0[3]}, o_, 0, 0, 0);   \
        o_ = __builtin_amdgcn_mfma_f32_32x32x16_bf16(pa1, (bf16x8){l1[0], l1[1], l1[2], l1[3], h1[0], h1[1], h1[2], h1[3]}, o_, 0, 0, 0);   \
        o_ = __builtin_amdgcn_mfma_f32_32x32x16_bf16(pa2, (bf16x8){l2[0], l2[1], l2[2], l2[3], h2[0], h2[1], h2[2], h2[3]}, o_, 0, 0, 0);   \
        o_ = __builtin_amdgcn_mfma_f32_32x32x16_bf16(pa3, (bf16x8){l3[0], l3[1], l3[2], l3[3], h3[0], h3[1], h3[2], h3[3]}, o_, 0, 0, 0); } while (0)

struct KVSrc { const char* k0; const char* k1; unsigned vd0, vd1; int stride0, stride1, nsplit; };
__device__ __forceinline__ void kv_tile(const KVSrc& s, int j, const char*& kt, const char*& vt, int& strideB) {
    const bool first = j < s.nsplit;
    strideB = first ? s.stride0 : s.stride1;
    const size_t off = (size_t)(first ? j : j - s.nsplit) * 64 * strideB;
    kt = (first ? s.k0 : s.k1) + off; vt = kt + (first ? s.vd0 : s.vd1);
}
__device__ __forceinline__ void issue_V(LAS unsigned char* lds, int buf, const char* vt, int strideB, int wid, int lane) {
    const int kV = swap23(8 * wid + ((lane & 31) >> 2));
    const char* src = vt + (size_t)kV * strideB + (lane >> 5) * 64 + (lane & 3) * 16;
    LAS unsigned char* dst = lds + LV0 + buf * VBUF + wid * 4096;
#pragma unroll
    for (int jj = 0; jj < 4; ++jj) GLDS(src + jj * 128, dst + jj * 1024);
}

struct DItem { const bf16_t* q; KVSrc kv; int nt_lo, nt_hi; bf16_t* o; };
__device__ __forceinline__ void issue_K2(LAS unsigned char* lds, int buf, const char* kt, int strideB, int wid, int lane) {
    const int map = wid >> 2, jrow = wid & 3, rowL = 4 * jrow + (lane >> 4);
    const char* src = kt + (size_t)rowL * strideB + map * 256 + (((lane & 15) ^ rowL) << 4);
    LAS unsigned char* dst = lds + buf * KBUF + map * 16384 + jrow * 1024;
#pragma unroll
    for (int jj = 0; jj < 4; ++jj) GLDS(src + (size_t)jj * 16 * strideB, dst + jj * 4096);
}
constexpr float DSCALE = 0.08838834764831845f, DC2 = 1.4426950408889634f * DSCALE, DTHR = 6.f;

__device__ __forceinline__ void diff_item(const DItem& it, LAS unsigned char* lds, float lam, float post, const float* subw) {
    int tid = threadIdx.x; asm volatile("" : "+v"(tid));
    const int wid = __builtin_amdgcn_readfirstlane(tid >> 6), lane = tid & 63, r32 = lane & 31, hi = lane >> 5;
    const int grp = wid >> 2, wq = wid & 3;
    const int ntw = (wq < 2) ? it.nt_lo : it.nt_hi, NT = it.nt_lo > it.nt_hi ? it.nt_lo : it.nt_hi;
    LAS float* ws = (LAS float*)(lds + LDS_SCR) + wid * 64; LAS float* li_l = ws; LAS float* al_l = ws + 32;
    bf16x8 qr[8];
    if (ntw > 0) { const bf16_t* qp = it.q + (size_t)(wq * 32 + r32) * NIN + grp * 128 + hi * 8;
#pragma unroll
        for (int d0 = 0; d0 < 8; ++d0) qr[d0] = *(const bf16x8*)(qp + d0 * 16); }
    else {
#pragma unroll
        for (int d0 = 0; d0 < 8; ++d0) qr[d0] = (bf16x8){0, 0, 0, 0, 0, 0, 0, 0}; }
    f32x16 o[8];
#pragma unroll
    for (int d0 = 0; d0 < 8; ++d0) o[d0] = f32x16{};
    float m_reg = -1e30f, l_reg = 0.f;
    bf16x8 pa0 = {}, pa1 = {}, pa2 = {}, pa3 = {};
    const int xh = (r32 >> 1) & 7;
    LAS unsigned char* krd = lds + grp * 16384 + r32 * 256 + ((hi ^ (r32 & 1)) << 4);
    const int vb0 = (int)(uintptr_t)(lds + LV0) + v_rd_base(lane);
    const char* kt; const char* vt; int sB;
#define ISSUE_K(t_) do { kv_tile(it.kv, (t_), kt, vt, sB); issue_K2(lds, (t_) & 1, kt, sB, wid, lane); } while (0)
#define ISSUE_V(t_) do { kv_tile(it.kv, (t_), kt, vt, sB); issue_V(lds, (t_) & 1, vt, sB, wid, lane); } while (0)
#define WAIT_BAR(issued) do { if (issued) asm volatile("s_waitcnt vmcnt(4)" ::: "memory"); else asm volatile("s_waitcnt vmcnt(0)" ::: "memory"); WGBAR(); } while (0)
    ISSUE_K(0); ISSUE_V(0);
    asm volatile("s_waitcnt vmcnt(0)" ::: "memory"); WGBAR();
    if (grp == 1) { const bool is = 1 < NT; if (is) ISSUE_K(1); WAIT_BAR(is); }
    for (int t = 0; t < NT; ++t) {
        const bool isx = t + 1 < NT;
        if (isx) { if (grp == 0) ISSUE_K(t + 1); else ISSUE_V(t + 1); }
        if (t < ntw) {
            f32x16 p0 = f32x16{}, p1 = f32x16{};
            LAS unsigned char* kb = krd + (t & 1) * KBUF;
#pragma unroll
            for (int d0 = 0; d0 < 8; ++d0) { LAS unsigned char* a = kb + ((d0 ^ xh) << 5);
                const bf16x8 b0 = *(const LAS bf16x8*)a, b1 = *(const LAS bf16x8*)(a + 8192);
                p0 = __builtin_amdgcn_mfma_f32_32x32x16_bf16(b0, qr[d0], p0, 0, 0, 0);
                p1 = __builtin_amdgcn_mfma_f32_32x32x16_bf16(b1, qr[d0], p1, 0, 0, 0); }
            float pmax = p0[0];
#pragma unroll
            for (int r = 1; r < 16; ++r) pmax = fmaxf(pmax, p0[r]);
#pragma unroll
            for (int r = 0; r < 16; ++r) pmax = fmaxf(pmax, p1[r]);
            { auto rr = __builtin_amdgcn_permlane32_swap(__float_as_uint(pmax), __float_as_uint(pmax), false, false);
              pmax = fmaxf(__uint_as_float(rr[0]), __uint_as_float(rr[1])); }
            float mn, alpha;
            if (__builtin_expect(__all((pmax - m_reg) * DSCALE <= DTHR), 1)) { mn = m_reg; alpha = 1.f; }
            else { mn = fmaxf(m_reg, pmax); alpha = __builtin_amdgcn_exp2f((m_reg - mn) * DC2); m_reg = mn; }
            const float mnL = -mn * DC2;
            float ps = 0.f;
#pragma unroll
            for (int r = 0; r < 16; ++r) { p0[r] = __builtin_amdgcn_exp2f(fmaf(p0[r], DC2, mnL)); ps += p0[r]; }
#pragma unroll
            for (int r = 0; r < 16; ++r) { p1[r] = __builtin_amdgcn_exp2f(fmaf(p1[r], DC2, mnL)); ps += p1[r]; }
            { auto rr = __builtin_amdgcn_permlane32_swap(__float_as_uint(ps), __float_as_uint(ps), false, false);
              ps = __uint_as_float(rr[0]) + __uint_as_float(rr[1]); }
            l_reg = l_reg * alpha + ps;
            PK4(p0, 0, pa0); PK4(p0, 8, pa1); PK4(p1, 0, pa2); PK4(p1, 8, pa3);
            if (__any(alpha < 1.f)) {
                if (hi == 0) al_l[r32] = alpha;
                asm volatile("s_waitcnt lgkmcnt(0)" ::: "memory");
#pragma unroll
                for (int r = 0; r < 16; ++r) { const float a = al_l[crow(r, hi)];
#pragma unroll
                    for (int d0 = 0; d0 < 8; ++d0) o[d0][r] *= a; }
            }
        }
        WAIT_BAR(isx);
        const bool isy = (grp == 0) ? (t + 1 < NT) : (t + 2 < NT);
        if (isy) { if (grp == 0) ISSUE_V(t + 1); else ISSUE_K(t + 2); }
        if (t < ntw) {
            const int vb = vb0 + (t & 1) * VBUF;
            PV_D0(o[0], vb, 0); PV_D0(o[1], vb, 1); PV_D0(o[2], vb, 2); PV_D0(o[3], vb, 3);
            PV_D0(o[4], vb, 4); PV_D0(o[5], vb, 5); PV_D0(o[6], vb, 6); PV_D0(o[7], vb, 7);
        }
        WAIT_BAR(isy);
    }
    if (grp == 0) WGBAR();
#undef ISSUE_K
#undef ISSUE_V
    const bool active = ntw > 0;
    if (active) {
        if (hi == 0) li_l[r32] = (grp == 0 ? 1.f : -lam) / l_reg;
        asm volatile("s_waitcnt lgkmcnt(0)" ::: "memory");
#pragma unroll
        for (int r = 0; r < 16; ++r) { const float a = li_l[crow(r, hi)];
#pragma unroll
            for (int d0 = 0; d0 < 8; ++d0) o[d0][r] *= a; }
        if (grp == 1) {
#pragma unroll
            for (int r = 0; r < 16; ++r) { LAS float* xp = (LAS float*)(lds + (wq * 32 + crow(r, hi)) * 1024) + r32;
#pragma unroll
                for (int d0 = 0; d0 < 8; ++d0) xp[d0 * 32] = o[d0][r]; }
        }
    }
    asm volatile("s_waitcnt lgkmcnt(0)" ::: "memory"); WGBAR();
    if (active && grp == 0) {
        float sw[8];
#pragma unroll
        for (int d0 = 0; d0 < 8; ++d0) sw[d0] = subw[d0 * 32 + r32] * post;
#pragma unroll
        for (int r = 0; r < 16; ++r) {
            const int row = wq * 32 + crow(r, hi);
            LAS float* xp = (LAS float*)(lds + row * 1024) + r32;
            float ssq = 0.f;
#pragma unroll
            for (int d0 = 0; d0 < 8; ++d0) { o[d0][r] += xp[d0 * 32]; ssq += o[d0][r] * o[d0][r]; }
#pragma unroll
            for (int sh = 1; sh < 32; sh <<= 1) ssq += __shfl_xor(ssq, sh);
            const float rs = 1.0f / sqrtf(ssq * (1.0f / 256.0f) + EPS);
            const bf16_t* gp = it.q + 3072 + (size_t)row * NIN + r32;
            bf16_t* op = it.o + (size_t)row * D + r32;
#pragma unroll
            for (int d0 = 0; d0 < 8; ++d0) {
                const float gv = bf2f(gp[d0 * 32]);
                const float val = o[d0][r] * rs * sw[d0] * gv / (1.0f + __expf(-gv));
                const float vn = __shfl_xor(val, 1);
                if ((r32 & 1) == 0) *(unsigned*)(op + d0 * 32) = cvtpk(val, vn);
            }
        }
    }
    asm volatile("s_waitcnt vmcnt(0) lgkmcnt(0)" ::: "memory"); WGBAR();
}

struct SItem { const bf16_t* q; KVSrc kv; int P0, nrows, jstart; bf16_t* o; };
__device__ __forceinline__ void issue_K1(LAS unsigned char* lds, int buf, const char* kt, int strideB, int wid, int lane) {
    const int rowL = 2 * wid + (lane >> 5);
    const char* src = kt + (size_t)rowL * strideB + (((lane & 31) ^ rowL) << 4);
    LAS unsigned char* dst = lds + buf * KBUF + wid * 1024;
#pragma unroll
    for (int jj = 0; jj < 4; ++jj) GLDS(src + (size_t)jj * 16 * strideB, dst + jj * 8192);
}
constexpr float LOG2E = 1.4426950408889634f, LN2 = 0.6931471805599453f;

#define SB_HALF(HALF_, PA, PB) do {                                                                                                                   \
        f32x16 z = f32x16{};                                                                                                                        \
        _Pragma("unroll") for (int d0 = 0; d0 < 16; ++d0) { const bf16x8 kf = *(const LAS bf16x8*)(kb + ((d0 ^ xh) << 5) + (HALF_) * 16384);         \
            z = __builtin_amdgcn_mfma_f32_32x32x16_bf16(kf, qr[d0], z, 0, 0, 0); }                                                                  \
        float L[16];                                                                                                                                \
        _Pragma("unroll") for (int r = 0; r < 16; ++r) { const float t_ = __builtin_amdgcn_exp2f(-fabsf(z[r]) * LOG2E);                               \
            L[r] = -(fmaxf(z[r], 0.f) + LN2 * __builtin_amdgcn_logf(1.0f + t_));                                                                    \
            if (diag && (32 * (HALF_) + crow(r, hi)) >= lim) L[r] = 0.f; }                                                                           \
        float Te[4], To[4];                                                                                                                         \
        _Pragma("unroll") for (int i = 0; i < 4; ++i) { L[4 * i + 2] += L[4 * i + 3]; L[4 * i + 1] += L[4 * i + 2]; L[4 * i] += L[4 * i + 1];       \
            auto rr = __builtin_amdgcn_permlane32_swap(__float_as_uint(L[4 * i]), __float_as_uint(L[4 * i]), false, false);                          \
            Te[i] = __uint_as_float(rr[0]); To[i] = __uint_as_float(rr[1]); }                                                                        \
        float run = C;                                                                                                                              \
        _Pragma("unroll") for (int i = 3; i >= 0; --i) { const float eo = run; run += To[i]; const float ee = run; run += Te[i];                    \
            const float off = hi ? eo : ee;                                                                                                         \
            _Pragma("unroll") for (int e = 0; e < 4; ++e) { const int r = 4 * i + e;                                                                  \
                float a = __builtin_amdgcn_exp2f((z[r] + L[r] + off) * LOG2E);                                                                      \
                if (diag && (32 * (HALF_) + crow(r, hi)) >= lim) a = 0.f;                                                                            \
                z[r] = a; } }                                                                                                                       \
        C = run;                                                                                                                                    \
        PK4(z, 0, PA); PK4(z, 8, PB);                                                                                                               \
    } while (0)

__device__ __forceinline__ void sb_item(const SItem& it, LAS unsigned char* lds) {
    int tid = threadIdx.x; asm volatile("" : "+v"(tid));
    const int wid = __builtin_amdgcn_readfirstlane(tid >> 6), lane = tid & 63, r32 = lane & 31, hi = lane >> 5;
    const int dh = wid >> 2, wq = wid & 3;
    const bool active = wq * 32 < it.nrows;
    volatile LAS unsigned* flags = (volatile LAS unsigned*)(lds + LDS_MISC + 64);
    bf16x8 qr[16];
    if (active) { const bf16_t* qp = it.q + (size_t)(wq * 32 + r32) * NIN + hi * 8;
#pragma unroll
        for (int d0 = 0; d0 < 16; ++d0) qr[d0] = *(const bf16x8*)(qp + d0 * 16); }
    else {
#pragma unroll
        for (int d0 = 0; d0 < 16; ++d0) qr[d0] = (bf16x8){0, 0, 0, 0, 0, 0, 0, 0}; }
    f32x16 o[4];
#pragma unroll
    for (int dd = 0; dd < 4; ++dd) o[dd] = f32x16{};
    float C = 0.f;
    const int P0w = it.P0 + 32 * wq, jw = P0w >> 6, lim = (P0w & 63) + r32;
    const int xh = (r32 >> 1) & 7;
    LAS unsigned char* krd = lds + r32 * 512 + ((hi ^ (r32 & 1)) << 4);
    const int vb0 = (int)(uintptr_t)(lds + LV0) + v_rd_base(lane) + dh * 4 * 512;
    const char* kt; const char* vt; int sB;
    bool done = !active;
    kv_tile(it.kv, it.jstart, kt, vt, sB); issue_K1(lds, 0, kt, sB, wid, lane); issue_V(lds, 0, vt, sB, wid, lane);
    asm volatile("s_waitcnt vmcnt(0)" ::: "memory"); WGBAR();
    for (int itn = 0;; ++itn) {
        const int j = it.jstart - itn, b = itn & 1;
        if (j > 0) { kv_tile(it.kv, j - 1, kt, vt, sB); issue_K1(lds, b ^ 1, kt, sB, wid, lane); issue_V(lds, b ^ 1, vt, sB, wid, lane); }
        if (!done && j <= jw) {
            const bool diag = (j == jw);
            LAS unsigned char* kb = krd + b * KBUF;
            bf16x8 pa0, pa1, pa2, pa3;
            SB_HALF(1, pa2, pa3);
            SB_HALF(0, pa0, pa1);
            const int vb = vb0 + b * VBUF;
            PV_D0(o[0], vb, 0); PV_D0(o[1], vb, 1); PV_D0(o[2], vb, 2); PV_D0(o[3], vb, 3);
            if (__all(C <= -104.f)) done = true;
        }
        if (lane == 0) flags[b * 8 + wid] = done ? 1u : 0u;
        asm volatile("s_waitcnt vmcnt(0) lgkmcnt(0)" ::: "memory"); WGBAR();
        if (j == 0) break;
        const unsigned f = (lane < 8) ? flags[b * 8 + lane] : 1u;
        if (!__any(f == 0u)) break;
    }
    asm volatile("s_waitcnt vmcnt(0) lgkmcnt(0)" ::: "memory"); WGBAR();
    if (active) {
#pragma unroll
        for (int r = 0; r < 16; ++r) {
            const int row = wq * 32 + crow(r, hi);
            const bf16_t* gp = it.q + 3072 + (size_t)row * NIN + dh * 128 + r32;
            bf16_t* op = it.o + (size_t)row * D + dh * 128 + r32;
#pragma unroll
            for (int dd = 0; dd < 4; ++dd) {
                const float gv = bf2f(gp[dd * 32]);
                const float val = o[dd][r] * gv / (1.0f + __expf(-gv));
                const float vn = __shfl_xor(val, 1);
                if ((r32 & 1) == 0) *(unsigned*)(op + dd * 32) = cvtpk(val, vn);
            }
        }
    }
}
}

#define CAS __attribute__((address_space(4)))
#define KARGS() const CAS unsigned char* kp_ = (const CAS unsigned char*)__builtin_amdgcn_kernarg_segment_ptr(); asm volatile("" : "+s"(kp_))
#define KIN(i) as_global(*(const float* const CAS*)(kp_ + 8 * (i)))
#define KOUT() as_global(*(float* const CAS*)(kp_ + 80))
#define KWS() as_global(*(unsigned char* const CAS*)(kp_ + 88))
__global__ void __launch_bounds__(NTHR, 2) fwd(const float* in0, const float* in1, const float* in2, const float* in3, const float* in4, const float* in5, const float* in6,
                                               const float* in7, const float* in8, const float* in9, float* out_, unsigned char* ws_, int ph_lo, int ph_hi) {
    extern __shared__ __attribute__((aligned(16))) unsigned char lds_raw[];
    LAS unsigned char* lds = (LAS unsigned char*)lds_raw;
    const int G = gridDim.x, bx = blockIdx.x;
    volatile LAS unsigned* misc = (volatile LAS unsigned*)(lds + LDS_MISC);
    if (threadIdx.x < 64) misc[threadIdx.x] = 0u;
    __syncthreads();
    XcdBarrier bar; bar.x = 0; bar.st = misc;
    { KARGS(); bar.bar = (unsigned*)(KWS() + WS_CTL) + CW_BAR; }
    if (!MK_PER_PHASE) bar = xcd_barrier_post(bar.bar, misc);
#define GRID_BAR() do { if (!MK_PER_PHASE) xcd_barrier(bar); } while (0)
    int lo, hi_; { KARGS(); lo = *(const int CAS*)(kp_ + 96); hi_ = *(const int CAS*)(kp_ + 100); }
#define IN(k) (lo <= (k) && (k) < hi_)
#define PHASE_PTRS() \
    KARGS(); unsigned char* ws = KWS(); \
    unsigned* ctl = (unsigned*)(ws + WS_CTL); (void)ctl; \
    bf16_t* H = (bf16_t*)(ws + WS_H); bf16_t* QKVG = (bf16_t*)(ws + WS_QKVG); float* Y = (float*)(ws + WS_Y); (void)H; (void)QKVG; (void)Y; \
    float* out = KOUT(); (void)out;
    if (IN(0)) {
        PHASE_PTRS();
        transpose_weights(KIN(5), (bf16_t*)(ws + WS_WIN), NIN, DEPTH, (LAS float*)lds);
        transpose_weights(KIN(6), (bf16_t*)(ws + WS_WOUT), D, DEPTH, (LAS float*)lds);
        rope_table((float*)(ws + WS_COS), (float*)(ws + WS_SIN));
        convert_bf16(KIN(2), (bf16_t*)(ws + WS_CK), (size_t)DEPTH * DBATCH * PAST * D);
        convert_bf16(KIN(3), (bf16_t*)(ws + WS_CV), (size_t)DEPTH * DBATCH * PAST * D);
        norm_phase(KIN(0), KIN(1) - (size_t)MP * D, KIN(4), H, nullptr, nullptr, 0);
        GRID_BAR();
    }
    for (int l = 0; l < DEPTH; ++l) {
        const int pb = 1 + 4 * l;
        const bool even = (l & 1) == 0;
        if (IN(pb)) {
            PHASE_PTRS();
            bf16_t* WIN = (bf16_t*)(ws + WS_WIN); float* COS = (float*)(ws + WS_COS);
            pg8::Gemm g{H, WIN + (size_t)l * NIN * D, MTOT, NIN, D}; pg8::StaticOrder S; S.init(MTOT, NIN, G, bx);
            EpiIn E{QKVG, out, COS, l};
#ifndef NO_GIN
            pg8::gemm_phase<EpiIn>(lds, g, S, E);
#endif
            GRID_BAR();
        }
        if (IN(pb + 1)) {
            PHASE_PTRS();
            bf16_t* CK = (bf16_t*)(ws + WS_CK);
            if (even) {
                const int lane = ltid() & 63;
                const float* lf = KIN(7) + (size_t)(l >> 1) * 4 * 128;
                const float s1 = wave_sum(lf[lane] * lf[128 + lane] + lf[64 + lane] * lf[192 + lane]);
                const float s2 = wave_sum(lf[256 + lane] * lf[384 + lane] + lf[320 + lane] * lf[448 + lane]);
                const float lam_init = (l == 0) ? 0.2f : 0.47071301834358406f;
                const float lam = __expf(s1) - __expf(s2) + lam_init;
                const float* subw = KIN(8) + (size_t)(l >> 1) * 256;
                for (int id = bx; id < 576; id += G) {
                    if (id < 512) {
                        const int bh = id & 7, pi = id >> 3, b = bh >> 2, h = bh & 3;
                        for (int pass = 0; pass < 2; ++pass) {
                            const int x = pass == 0 ? 127 - pi : pi;
                            const size_t row0 = (size_t)b * SEQ + (size_t)x * 128;
                            att::DItem it;
                            it.q = QKVG + row0 * NIN + h * 256;
                            it.kv.k0 = (const char*)(QKVG + (size_t)b * SEQ * NIN + 1024 + h * 256); it.kv.k1 = it.kv.k0; it.kv.vd0 = 2048u; it.kv.vd1 = 2048u;
                            it.kv.stride0 = NIN * 2; it.kv.stride1 = NIN * 2; it.kv.nsplit = 1 << 30;
                            it.nt_lo = 2 * x + 1; it.nt_hi = 2 * x + 2;
                            it.o = H + row0 * D + h * 256;
#ifndef NO_DIFF
                            att::diff_item(it, lds, lam, 1.0f - lam_init, subw);
#endif
                        }
                    } else {
                        const int s = id - 512, sb = s >> 2, h = s & 3;
                        const size_t row0 = (size_t)MP + (size_t)sb * DSEQ;
                        att::DItem it;
                        it.q = QKVG + row0 * NIN + h * 256;
                        it.kv.k0 = (const char*)(CK + ((size_t)(l * DBATCH + sb) * PAST) * D + h * 256); it.kv.vd0 = (unsigned)(WS_CV - WS_CK);
                        it.kv.stride0 = D * 2; it.kv.nsplit = PAST / 64;
                        it.kv.k1 = (const char*)(QKVG + row0 * NIN + 1024 + h * 256); it.kv.vd1 = 2048u; it.kv.stride1 = NIN * 2;
                        it.nt_lo = PAST / 64 + 1; it.nt_hi = 0;
                        it.o = H + row0 * D + h * 256;
#ifndef NO_DIFF
                        att::diff_item(it, lds, lam, 1.0f - lam_init, subw);
#endif
                    }
                }
            } else {
                for (int id = bx; id < 1088; id += G) {
                    const bool pr = id < 1024;
                    const int bh = id & 7, x = id >> 3, s = id - 1024;
                    const int b = bh >> 2, h = pr ? (bh & 3) : (s & 3), sb = s >> 2;
                    const size_t row0 = pr ? (size_t)b * SEQ + (size_t)x * 128 : (size_t)MP + (size_t)sb * DSEQ;
                    const size_t krow = pr ? (size_t)b * SEQ : row0;
                    const bf16_t* knew = QKVG + krow * NIN + 1024 + h * 256;
                    const size_t coff = ((size_t)(l * DBATCH + sb) * PAST) * D + h * 256;
                    att::SItem it;
                    it.q = QKVG + row0 * NIN + h * 256;
                    it.kv.k1 = (const char*)knew; it.kv.vd1 = 2048u; it.kv.stride1 = NIN * 2;
                    it.kv.k0 = pr ? (const char*)knew : (const char*)(CK + coff); it.kv.vd0 = pr ? 2048u : (unsigned)(WS_CV - WS_CK);
                    it.kv.stride0 = pr ? NIN * 2 : D * 2; it.kv.nsplit = pr ? (1 << 30) : PAST / 64;
                    it.P0 = pr ? x * 128 : PAST; it.nrows = pr ? 128 : DSEQ; it.jstart = pr ? 2 * x + 1 : PAST / 64;
                    it.o = H + row0 * D + h * 256;
#ifndef NO_SB
                    att::sb_item(it, lds);
#endif
                }
            }
            GRID_BAR();
        }
        if (IN(pb + 2)) {
            PHASE_PTRS();
            bf16_t* WOUT = (bf16_t*)(ws + WS_WOUT);
            pg8::Gemm g{H, WOUT + (size_t)l * D * D, MTOT, D, D}; pg8::StaticOrder S; S.init(MTOT, D, G, bx);
            EpiOut E{l == 0 ? KIN(0) : Y, l == 0 ? KIN(1) - (size_t)MP * D : Y, Y};
#ifndef NO_GOUT
            pg8::gemm_phase<EpiOut>(lds, g, S, E);
#endif
            GRID_BAR();
        }
        if (IN(pb + 3)) {
            PHASE_PTRS();
            if (l < DEPTH - 1) { norm_phase(Y, Y, KIN(4) + (size_t)(l + 1) * D, H, nullptr, nullptr, 0); GRID_BAR(); }
            else norm_phase(Y, Y, KIN(9), nullptr, out + OY_P, out + OY_S - (size_t)MP * D, 1);
        }
    }
#undef IN
#undef GRID_BAR
}

extern "C" void kernel_launch(void* const* d_in, const int* in_sizes, int n_in, void* d_out, int out_size, void* d_ws, size_t ws_size, hipStream_t stream) {
    static int grid = 0;
    if (grid == 0) {
        if (n_in != 10 || (size_t)out_size != O_END || ws_size < WS_END) { fprintf(stderr, "kernel_launch: unexpected shapes (n_in %d out %d ws %zu, want 10 / %zu / >= %zu)\n", n_in, out_size, ws_size, (size_t)O_END, (size_t)WS_END); grid = -1; return; }
        int dev = 0, cus = 0, per_cu = 0;
        if (hipGetDevice(&dev) != hipSuccess || hipDeviceGetAttribute(&cus, hipDeviceAttributeMultiprocessorCount, dev) != hipSuccess) { grid = -1; return; }
        if (hipFuncSetAttribute((const void*)fwd, hipFuncAttributeMaxDynamicSharedMemorySize, LDS_BYTES) != hipSuccess) { fprintf(stderr, "kernel_launch: hipFuncSetAttribute failed\n"); grid = -1; return; }
        if (hipOccupancyMaxActiveBlocksPerMultiprocessor(&per_cu, (const void*)fwd, NTHR, LDS_BYTES) != hipSuccess || per_cu < 1) { fprintf(stderr, "kernel_launch: occupancy query says %d blocks per CU\n", per_cu); }
        (void)hipGetLastError();
        grid = cus;
    }
    if (grid < 0) return;
    (void)hipMemsetAsync((char*)d_ws + WS_CTL, 0, CTL_BYTES, stream);
    const float* in[10];
    for (int i = 0; i < 10; ++i) in[i] = (const float*)d_in[i];
#if MK_PER_PHASE
    for (int p = 0; p < 17; ++p) hipLaunchKernelGGL(fwd, dim3(grid), dim3(NTHR), LDS_BYTES, stream, in[0], in[1], in[2], in[3], in[4], in[5], in[6], in[7], in[8], in[9], (float*)d_out, (unsigned char*)d_ws, p, p + 1);
#else
    hipLaunchKernelGGL(fwd, dim3(grid), dim3(NTHR), LDS_BYTES, stream, in[0], in[1], in[2], in[3], in[4], in[5], in[6], in[7], in[8], in[9], (float*)d_out, (unsigned char*)d_ws, 0, 17);
#endif
}
```

```cpp
#include <hip/hip_runtime.h>
#include <cstdio>
#include <cstdint>

#ifndef MK_PER_PHASE
#define MK_PER_PHASE 0
#endif

constexpr int D = 1024, NBATCH = 2, SEQ = 16384, DEPTH = 4, DBATCH = 16, DSEQ = 64, PAST = 2048;
constexpr int MP = NBATCH * SEQ, MS = DBATCH * DSEQ, MTOT = MP + MS;
constexpr int NIN = 4 * D;
constexpr float EPS = 1e-6f;
constexpr size_t OY_P = 0, OY_S = OY_P + (size_t)MP * D, OK_P = OY_S + (size_t)MS * D, OV_P = OK_P + (size_t)DEPTH * MP * D,
                 OK_S = OV_P + (size_t)DEPTH * MP * D, OV_S = OK_S + (size_t)DEPTH * MS * D, O_END = OV_S + (size_t)DEPTH * MS * D;
constexpr size_t WS_CTL = 0, CTL_BYTES = 65536;
constexpr size_t WS_WIN = WS_CTL + CTL_BYTES;
constexpr size_t WS_WOUT = WS_WIN + (size_t)DEPTH * NIN * D * 2;
constexpr size_t WS_COS = WS_WOUT + (size_t)DEPTH * D * D * 2;
constexpr size_t WS_SIN = WS_COS + (size_t)SEQ * 64 * 4;
constexpr size_t WS_H = WS_SIN + (size_t)SEQ * 64 * 4;
constexpr size_t WS_QKVG = WS_H + (size_t)MTOT * D * 2;
constexpr size_t WS_Y = WS_QKVG + (size_t)MTOT * NIN * 2;
constexpr size_t WS_CK = WS_Y + (size_t)MTOT * D * 4;
constexpr size_t WS_CV = WS_CK + (size_t)DEPTH * DBATCH * PAST * D * 2;
constexpr size_t WS_END = WS_CV + (size_t)DEPTH * DBATCH * PAST * D * 2;
constexpr int CW_BAR = 0;
constexpr int CW_KM = 4096;
constexpr int CW_TMO = 4096 + 256;

typedef unsigned short bf16_t;
typedef short bf16x8 __attribute__((ext_vector_type(8)));
typedef short s16x4 __attribute__((ext_vector_type(4)));
typedef float f32x16 __attribute__((ext_vector_type(16)));
typedef float f32x4 __attribute__((ext_vector_type(4)));
typedef float f32x2 __attribute__((ext_vector_type(2)));
typedef unsigned u32x4 __attribute__((ext_vector_type(4)));
typedef unsigned u32x2 __attribute__((ext_vector_type(2)));
#define LAS __attribute__((address_space(3)))
#define GAS __attribute__((address_space(1)))
template <class T> __device__ __forceinline__ T* as_global(T* p) { return (T*)(GAS T*)p; }

__device__ __forceinline__ unsigned cvtpk(float lo, float hi) { unsigned r; asm volatile("v_cvt_pk_bf16_f32 %0, %1, %2" : "=v"(r) : "v"(lo), "v"(hi)); return r; }
__device__ __forceinline__ float bf_lo(unsigned w) { return __uint_as_float(w << 16); }
__device__ __forceinline__ float bf_hi(unsigned w) { return __uint_as_float(w & 0xffff0000u); }
__device__ __forceinline__ float bf2f(bf16_t b) { return __uint_as_float(((unsigned)b) << 16); }
template <int M> __device__ __forceinline__ float xor_lane(float v) { return __int_as_float(__builtin_amdgcn_ds_swizzle(__float_as_int(v), (M << 10) | 0x1f)); }
__device__ __forceinline__ float wave_sum(float v) {
    v += xor_lane<1>(v); v += xor_lane<2>(v); v += xor_lane<4>(v); v += xor_lane<8>(v); v += xor_lane<16>(v);
    auto rr = __builtin_amdgcn_permlane32_swap(__float_as_uint(v), __float_as_uint(v), false, false); return __uint_as_float(rr[0]) + __uint_as_float(rr[1]); }
__device__ __forceinline__ float half_sum(float v) { v += xor_lane<1>(v); v += xor_lane<2>(v); v += xor_lane<4>(v); v += xor_lane<8>(v); v += xor_lane<16>(v); return v; }

#define XB_TMO      128
#define XB_XCNT(j)  (256  + 64 * (j))
#define XB_XSUB(j)  (1280 + 64 * (j))
#define XB_XGEN(j)  (2304 + 64 * (j))
#define XB_TOP      3328
#define XB_TOPGEN   3392
#define XCD_BAR_WORDS 3456
#define XB_SPIN_CAP (1u << 22)
__device__ __forceinline__ unsigned xb_ld(unsigned* p)              { return __hip_atomic_load(p, __ATOMIC_RELAXED, __HIP_MEMORY_SCOPE_AGENT); }
__device__ __forceinline__ unsigned xb_add(unsigned* p, unsigned v) { return __hip_atomic_fetch_add(p, v, __ATOMIC_RELAXED, __HIP_MEMORY_SCOPE_AGENT); }
__device__ __forceinline__ unsigned xb_xcc_id() { return (unsigned)__builtin_amdgcn_s_getreg((3 << 11) | 20) & 0xFu; }
#define XB_SPIN(cond, bar) do { unsigned _sp = 0; while (cond) { __builtin_amdgcn_s_sleep(1); \
    if ((++_sp & 255u) == 0u) { if (xb_ld(&(bar)[XB_TMO])) break; if (_sp > XB_SPIN_CAP) { atomicAdd(&(bar)[XB_TMO], 1u); break; } } } } while (0)
struct XcdBarrier { unsigned* bar; unsigned x; volatile LAS unsigned* st; };
__device__ __forceinline__ XcdBarrier xcd_barrier_post(unsigned* bar, volatile LAS unsigned* st) {
    XcdBarrier b; b.bar = bar; b.x = xb_xcc_id(); b.st = st;
    if (threadIdx.x == 0) (void)xb_add(&bar[XB_XCNT(b.x)], 1u);
    return b;
}
__device__ __forceinline__ void xcd_barrier_complete(unsigned* bar, unsigned x, unsigned& nloc, unsigned& nx) {
    const unsigned G = gridDim.x * gridDim.y * gridDim.z;
    unsigned sum, cnt, mine, sp = 0u;
    for (;;) {
        sum = 0u; cnt = 0u; mine = 0u;
#pragma unroll
        for (unsigned j = 0; j < 16; ++j) { const unsigned c = xb_ld(&bar[XB_XCNT(j)]); sum += c; cnt += (c > 0u) ? 1u : 0u; mine = (j == x) ? c : mine; }
        if (sum == G) break;
        __builtin_amdgcn_s_sleep(1);
        if ((++sp & 255u) == 0u) { if (xb_ld(&bar[XB_TMO])) break; if (sp > XB_SPIN_CAP) { atomicAdd(&bar[XB_TMO], 1u); break; } }
    }
    nloc = mine > 0u ? mine : 1u; nx = cnt > 0u ? cnt : 1u;
}
__device__ __forceinline__ void xcd_barrier(const XcdBarrier& b) {
    asm volatile("s_waitcnt vmcnt(0)" ::: "memory");
    __syncthreads();
    if (threadIdx.x == 0) {
        unsigned* bar = b.bar;
        __builtin_amdgcn_s_waitcnt(0);
        unsigned nloc = b.st[0], nx = b.st[1];
        if (nloc == 0u) { xcd_barrier_complete(bar, b.x, nloc, nx); b.st[0] = nloc; b.st[1] = nx; }
        const unsigned old = xb_add(&bar[XB_XSUB(b.x)], 1u);
        const unsigned gen = old / nloc;
        if (old + 1u == (gen + 1u) * nloc) {
            __builtin_amdgcn_fence(__ATOMIC_RELEASE, "agent");
            asm volatile("s_waitcnt vmcnt(0)" ::: "memory");
            const unsigned og = xb_add(&bar[XB_TOP], 1u);
            const unsigned tg = og / nx;
            if (og + 1u == (tg + 1u) * nx) xb_add(&bar[XB_TOPGEN], 1u);
            else XB_SPIN(xb_ld(&bar[XB_TOPGEN]) == tg, bar);
            __builtin_amdgcn_fence(__ATOMIC_ACQUIRE, "agent");
            xb_add(&bar[XB_XGEN(b.x)], 1u);
            asm volatile("s_waitcnt vmcnt(0)" ::: "memory");
        } else {
            XB_SPIN(xb_ld(&bar[XB_XGEN(b.x)]) == gen, bar);
            __builtin_amdgcn_fence(__ATOMIC_ACQUIRE, "agent");
            asm volatile("s_waitcnt vmcnt(0)" ::: "memory");
        }
    }
    __syncthreads();
}

namespace pg8 {
constexpr int BM = 256, BK = 64, HALF = 128, HTB = HALF * BK * 2, STAGE_BYTES = 8 * HTB, NXCD = 8, WGM = 8;
__host__ __device__ __forceinline__ int lds_byte(int r, int c) { const int st = (r >> 4) * 2 + (c >> 5), rr = r & 15, cc = c & 31, ob = rr * 64 + cc * 2; return st * 1024 + (ob ^ (((ob >> 9) & 1) << 5)); }
__host__ __device__ __forceinline__ void stage_rc(int b, int& R, int& C) { const int st = b / 1024, sb = b % 1024, swz = sb ^ (((sb >> 9) & 1) << 5); R = (st >> 1) * 16 + swz / 64; C = (st & 1) * 32 + (swz % 64) / 2; }
__host__ __device__ __forceinline__ int perm32(int rho) { const int n = rho >> 4, i = rho & 15; return 8 * (i >> 2) + 4 * n + (i & 3); }
struct Unit { int pm, pn; };
struct Gemm { const bf16_t* A; const bf16_t* Bt; };
template <int M_, int N_> struct StaticOrder {
    static constexpr int nM = M_ / BM, nN = N_ / BM, nwg = nM * nN;
    int G, c;
    __host__ __device__ void init(int G_, int c_) { G = G_; c = c_; }
    __host__ __device__ bool next(int i, Unit& u) const {
        const long L = (long)i * G + c; if (L >= nwg) return false;
        int wgid = (int)L; { const int q = nwg / NXCD, r = nwg % NXCD, xcd = wgid % NXCD, off = wgid / NXCD; wgid = (xcd < r ? xcd * (q + 1) : r * (q + 1) + (xcd - r) * q) + off; }
        const int nig = WGM * nN, gid = wgid / nig, fm = gid * WGM, gsz = (nM - fm) < WGM ? (nM - fm) : WGM;
        u.pm = fm + ((wgid % nig) % gsz); u.pn = (wgid % nig) / gsz; return true;
    }
};

template <class Epi, int M_, int N_, int K_>
__device__ __forceinline__ void gemm_phase(LAS unsigned char* lds, const Gemm g, const StaticOrder<M_, N_>& S, const Epi& E) {
    int tid = threadIdx.x; asm volatile("" : "+v"(tid));
    const int wid = __builtin_amdgcn_readfirstlane(tid >> 6), lane = tid & 63, wr = wid >> 2, wc = wid & 3, fr = lane & 15, fq = lane >> 4;
    constexpr int K = K_, nt = K / BK;
    unsigned voffA[2], voffB[2];
#pragma unroll
    for (int i = 0; i < 2; ++i) { int R, C; stage_rc(tid * 16 + i * 8192, R, C); const int Rb = Epi::brow(R);
        voffA[i] = (unsigned)(R * K + C) * 2u; voffB[i] = (unsigned)(Rb * K + C) * 2u; }
    constexpr size_t kstep = (size_t)(BK * 2);
    constexpr size_t hstep = (size_t)HALF * K * 2;
    constexpr size_t hstepB = (size_t)Epi::BHROWS * K * 2;
    constexpr size_t tstep = 2 * hstep;
    const unsigned ldsw = (unsigned)wid * 1024u;
    const int aoff = lds_byte(wr * 64 + fr, fq * 8), boff = lds_byte(wc * 32 + fr, fq * 8);
#define PG8_SA(b, h) (((b) * 2 + (h)) * HTB)
#define PG8_SB(b, h) ((4 + (b) * 2 + (h)) * HTB)
#define PG8_STAGE(bufoff, gbase, voff) do { _Pragma("unroll") for (int _i = 0; _i < 2; ++_i) \
        __builtin_amdgcn_global_load_lds((const unsigned*)((const char*)(gbase) + (voff)[_i]), (LAS unsigned*)(lds + (bufoff) + ldsw + _i * 8192), 16, 0, 0); } while (0)
#define PG8_LDA(dst, b, h) do { _Pragma("unroll") for (int m = 0; m < 4; ++m) _Pragma("unroll") for (int k = 0; k < 2; ++k) dst[m][k] = *(const LAS bf16x8*)(lds + PG8_SA(b, h) + aoff + m * 2048 + k * 1024); } while (0)
#define PG8_LDB(dst, b, h) do { _Pragma("unroll") for (int n = 0; n < 2; ++n) _Pragma("unroll") for (int k = 0; k < 2; ++k) dst[n][k] = *(const LAS bf16x8*)(lds + PG8_SB(b, h) + boff + n * 2048 + k * 1024); } while (0)
#define PG8_MMA(ai, bj, At, Bt) do { __builtin_amdgcn_s_setprio(1); _Pragma("unroll") for (int m = 0; m < 4; ++m) _Pragma("unroll") for (int n = 0; n < 2; ++n) _Pragma("unroll") for (int k = 0; k < 2; ++k) \
        acc[ai][bj][m][n] = __builtin_amdgcn_mfma_f32_16x16x32_bf16(Bt[n][k], At[m][k], acc[ai][bj][m][n], 0, 0, 0); __builtin_amdgcn_s_setprio(0); } while (0)
#define PG8_WAIT_V(n) asm volatile("s_waitcnt vmcnt(" #n ")" ::: "memory")
#define PG8_WAIT_L(n) asm volatile("s_waitcnt lgkmcnt(" #n ")" ::: "memory")
#define PG8_BAR __builtin_amdgcn_s_barrier()
#define PG8_SCHED __builtin_amdgcn_sched_barrier(0)
    Unit cur, nxt; int ui = 0;
    if (!S.next(0, cur)) return;
    f32x4 acc[2][2][4][2];
#pragma unroll
    for (int a = 0; a < 2; ++a)
#pragma unroll
        for (int b = 0; b < 2; ++b)
#pragma unroll
            for (int m = 0; m < 4; ++m)
#pragma unroll
                for (int n = 0; n < 2; ++n) acc[a][b][m][n] = (f32x4){0.f, 0.f, 0.f, 0.f};
    bf16x8 At[4][2], B0[2][2], B1[2][2];
    const char* cA = (const char*)g.A + (size_t)cur.pm * tstep; const char* cB = (const char*)g.Bt + (size_t)cur.pn * tstep;
    PG8_STAGE(PG8_SB(0, 0), cB, voffB); PG8_STAGE(PG8_SA(0, 0), cA, voffA); PG8_STAGE(PG8_SB(0, 1), cB + hstepB, voffB); PG8_STAGE(PG8_SA(0, 1), cA + hstep, voffA);
    if (wr == 1) PG8_BAR;
    PG8_WAIT_V(4); PG8_BAR;
    PG8_STAGE(PG8_SB(1, 0), cB + kstep, voffB); PG8_STAGE(PG8_SA(1, 0), cA + kstep, voffA); PG8_STAGE(PG8_SB(1, 1), cB + hstepB + kstep, voffB);
    PG8_WAIT_V(6); PG8_BAR;
    for (;;) {
        const bool has_next = S.next(ui + 1, nxt);
        const char* nA = has_next ? (const char*)g.A + (size_t)nxt.pm * tstep : cA; const char* nB = has_next ? (const char*)g.Bt + (size_t)nxt.pn * tstep : cB;
        for (int t = 0; t < nt; t += 2) {
            const bool last = (t == nt - 2);
            const char* a1 = cA + (size_t)(t + 1) * kstep;
            const char* a2 = last ? nA : cA + (size_t)(t + 2) * kstep; const char* b2 = last ? nB : cB + (size_t)(t + 2) * kstep;
            const char* a3 = a2 + kstep; const char* b3 = b2 + kstep;
            PG8_LDB(B0, 0, 0); PG8_SCHED; PG8_LDA(At, 0, 0); PG8_STAGE(PG8_SA(1, 1), a1 + hstep, voffA);
            PG8_WAIT_L(8); PG8_BAR; PG8_WAIT_L(0); PG8_MMA(0, 0, At, B0); PG8_BAR; PG8_SCHED;
            PG8_LDB(B1, 0, 1); PG8_STAGE(PG8_SB(0, 0), b2, voffB);
            PG8_BAR; PG8_WAIT_L(0); PG8_MMA(0, 1, At, B1); PG8_BAR;
            PG8_LDA(At, 0, 1); PG8_STAGE(PG8_SA(0, 0), a2, voffA);
            PG8_BAR; PG8_WAIT_L(0); PG8_MMA(1, 0, At, B0); PG8_BAR; PG8_SCHED;
            PG8_STAGE(PG8_SB(0, 1), b2 + hstepB, voffB);
            PG8_WAIT_V(6); PG8_BAR; PG8_MMA(1, 1, At, B1); PG8_BAR;
            PG8_LDB(B0, 1, 0); PG8_SCHED; PG8_LDA(At, 1, 0); PG8_STAGE(PG8_SA(0, 1), a2 + hstep, voffA);
            PG8_WAIT_L(8); PG8_BAR; PG8_WAIT_L(0); PG8_MMA(0, 0, At, B0); PG8_BAR; PG8_SCHED;
            PG8_LDB(B1, 1, 1); PG8_STAGE(PG8_SB(1, 0), b3, voffB);
            PG8_BAR; PG8_WAIT_L(0); PG8_MMA(0, 1, At, B1); PG8_BAR;
            PG8_LDA(At, 1, 1); PG8_STAGE(PG8_SA(1, 0), a3, voffA);
            PG8_BAR; PG8_WAIT_L(0); PG8_MMA(1, 0, At, B0); PG8_BAR; PG8_SCHED;
            PG8_STAGE(PG8_SB(1, 1), b3 + hstepB, voffB);
            PG8_WAIT_V(6); PG8_BAR; PG8_MMA(1, 1, At, B1); PG8_BAR;
        }
        E(acc, cur, wr, wc, fr, fq);
        if (!has_next) break;
#pragma unroll
        for (int a = 0; a < 2; ++a)
#pragma unroll
            for (int b = 0; b < 2; ++b)
#pragma unroll
                for (int m = 0; m < 4; ++m)
#pragma unroll
                    for (int n = 0; n < 2; ++n) acc[a][b][m][n] = (f32x4){0.f, 0.f, 0.f, 0.f};
        cur = nxt; cA = nA; cB = nB; ++ui;
    }
    PG8_WAIT_V(0);
    if (wr == 0) PG8_BAR;
    PG8_BAR;
#undef PG8_SA
#undef PG8_SB
#undef PG8_STAGE
#undef PG8_LDA
#undef PG8_LDB
#undef PG8_MMA
#undef PG8_WAIT_V
#undef PG8_WAIT_L
#undef PG8_BAR
#undef PG8_SCHED
}
}

struct EpiIn {
    static constexpr int BHROWS = 64;
    __host__ __device__ static __forceinline__ int brow(int R) { const int wc = R >> 5; return 128 * (wc >> 1) + 32 * (wc & 1) + pg8::perm32(R & 31); }
    bf16_t* qkvg; float* out; const float* cosT; int l;
    __device__ __forceinline__ void operator()(const f32x4 (&acc)[2][2][4][2], const pg8::Unit& u, int wr, int wc, int fr, int fq) const {
        float* ob = out; asm volatile("" : "+s"(ob)); ob = as_global(ob);
        const int rope = (l & 1) ^ 1;
        float* outk_p = ob + OK_P + (size_t)l * MP * D; float* outv_p = ob + OV_P + (size_t)l * MP * D;
        float* outk_s = ob + OK_S + (size_t)l * MS * D; float* outv_s = ob + OV_S + (size_t)l * MS * D;
        const float* sinT = cosT + (size_t)SEQ * 64;
        const int sec = u.pn >> 2, ct = (u.pn & 3) * 256 + 128 * (wc >> 1) + 32 * (wc & 1) + 8 * fq;
        const int row0 = u.pm * 256 + wr * 64 + fr;
        const bool prompt = u.pm < (MP / 256);
        const bool dof = (sec == 1) || (sec == 2);
        float* fo = (sec == 1) ? (prompt ? outk_p : outk_s - (size_t)MP * D) : (prompt ? outv_p : outv_s - (size_t)MP * D);
        const bool dorope = rope && sec < 2;
        const float qs = (!rope && sec == 0) ? 0.0625f : 1.0f;
        const int dcol = 32 * (wc & 1) + 8 * fq;
#pragma unroll
        for (int ai = 0; ai < 2; ++ai)
#pragma unroll
            for (int m = 0; m < 4; ++m) {
                const int row = row0 + ai * 128 + m * 16;
                f32x4 v[2][2];
#pragma unroll
                for (int bj = 0; bj < 2; ++bj)
#pragma unroll
                    for (int n = 0; n < 2; ++n) v[bj][n] = acc[ai][bj][m][n] * qs;
                if (dorope) {
                    const int pos = prompt ? (row & (SEQ - 1)) : PAST + ((row - MP) & (DSEQ - 1));
#pragma unroll
                    for (int n = 0; n < 2; ++n) {
                        const f32x4 c = *(const f32x4*)(cosT + (size_t)pos * 64 + dcol + 4 * n), s = *(const f32x4*)(sinT + (size_t)pos * 64 + dcol + 4 * n);
                        const f32x4 x1 = v[0][n], x2 = v[1][n];
                        v[0][n] = x1 * c - x2 * s; v[1][n] = x2 * c + x1 * s;
                    }
                }
                bf16_t* qp = qkvg + (size_t)row * NIN + sec * 1024 + ct;
#pragma unroll
                for (int bj = 0; bj < 2; ++bj) {
                    u32x4 w; w.x = cvtpk(v[bj][0][0], v[bj][0][1]); w.y = cvtpk(v[bj][0][2], v[bj][0][3]); w.z = cvtpk(v[bj][1][0], v[bj][1][1]); w.w = cvtpk(v[bj][1][2], v[bj][1][3]);
                    *(u32x4*)(qp + bj * 64) = w;
                }
                if (dof) {
                    GAS float* fp = (GAS float*)(fo + (size_t)row * D + ct);
#pragma unroll
                    for (int bj = 0; bj < 2; ++bj) { __builtin_nontemporal_store(v[bj][0], (GAS f32x4*)(fp + bj * 64)); __builtin_nontemporal_store(v[bj][1], (GAS f32x4*)(fp + bj * 64 + 4)); }
                }
            }
    }
};
struct EpiOut {
    static constexpr int BHROWS = 128;
    __host__ __device__ static __forceinline__ int brow(int R) { return R; }
    const float* yin_p; const float* yin_s; float* yout;
    __device__ __forceinline__ void operator()(const f32x4 (&acc)[2][2][4][2], const pg8::Unit& u, int wr, int wc, int fr, int fq) const {
        const int row0 = u.pm * 256 + wr * 64 + fr, col0 = u.pn * 256 + wc * 32 + 4 * fq;
        const float* yi = (u.pm < (MP / 256)) ? yin_p : yin_s;
#pragma unroll
        for (int ai = 0; ai < 2; ++ai)
#pragma unroll
            for (int m = 0; m < 4; ++m) { const size_t ro = (size_t)(row0 + ai * 128 + m * 16) * D + col0;
#pragma unroll
                for (int bj = 0; bj < 2; ++bj)
#pragma unroll
                    for (int n = 0; n < 2; ++n) *(f32x4*)(yout + ro + bj * 128 + n * 16) = *(const f32x4*)(yi + ro + bj * 128 + n * 16) + acc[ai][bj][m][n]; }
    }
};

constexpr int NW = 8, NTHR = 512;
constexpr int LDS_MAIN = 131072, LDS_SCR = LDS_MAIN, LDS_SCR_BYTES = 8 * 512, LDS_MISC = LDS_SCR + LDS_SCR_BYTES, LDS_BYTES = LDS_MISC + 256;

__device__ __forceinline__ int ltid() { int t = threadIdx.x; asm volatile("" : "+v"(t)); return t; }
__device__ __forceinline__ void norm_phase(const float* xp, const float* xs  , const float* g, bf16_t* hb, float* op, float* os  , int mode) {
    const int tid = ltid(), lane = tid & 63, wid = tid >> 6;
    f32x4 gw[4];
#pragma unroll
    for (int i = 0; i < 2; ++i) { gw[2 * i] = *(const f32x4*)(g + i * 512 + lane * 8); gw[2 * i + 1] = *(const f32x4*)(g + i * 512 + lane * 8 + 4); }
    for (int row = blockIdx.x * NW + wid; row < MTOT; row += gridDim.x * NW) {
        const float* x = (row < MP ? xp : xs) + (size_t)row * D;
        f32x4 v[4];
#pragma unroll
        for (int i = 0; i < 2; ++i) { v[2 * i] = *(const f32x4*)(x + i * 512 + lane * 8); v[2 * i + 1] = *(const f32x4*)(x + i * 512 + lane * 8 + 4); }
        float s = 0.f;
#pragma unroll
        for (int i = 0; i < 4; ++i) s += v[i][0] * v[i][0] + v[i][1] * v[i][1] + v[i][2] * v[i][2] + v[i][3] * v[i][3];
        s = wave_sum(s);
        const float r = 1.0f / sqrtf(s * (1.0f / D) + EPS);
#pragma unroll
        for (int i = 0; i < 4; ++i) v[i] = v[i] * r * gw[i];
        if (mode == 0) {
#pragma unroll
            for (int i = 0; i < 2; ++i) { u32x4 w; w.x = cvtpk(v[2 * i][0], v[2 * i][1]); w.y = cvtpk(v[2 * i][2], v[2 * i][3]); w.z = cvtpk(v[2 * i + 1][0], v[2 * i + 1][1]); w.w = cvtpk(v[2 * i + 1][2], v[2 * i + 1][3]);
                *(u32x4*)(hb + (size_t)row * D + i * 512 + lane * 8) = w; }
        } else {
            float* o = (row < MP ? op : os) + (size_t)row * D;
#pragma unroll
            for (int i = 0; i < 2; ++i) { __builtin_nontemporal_store(v[2 * i], (f32x4*)(o + i * 512 + lane * 8)); __builtin_nontemporal_store(v[2 * i + 1], (f32x4*)(o + i * 512 + lane * 8 + 4)); }
        }
    }
}
__device__ __forceinline__ void transpose_weights(const float* W, bf16_t* Wt, int N, int nmat, LAS float* sm) {
    const int tid = ltid();
    const int tilesN = N / 64, tilesK = D / 128, per = tilesN * tilesK, total = per * nmat;
    for (int t = blockIdx.x; t < total; t += gridDim.x) {
        const int mat = t / per, tt = t % per, tk = tt / tilesN, tn = tt % tilesN;
        const float* src = W + (size_t)mat * D * N + (size_t)(tk * 128) * N + tn * 64;
        __syncthreads();
#pragma unroll
        for (int p = 0; p < 4; ++p) { const int r = p * 32 + (tid >> 4), c = (tid & 15) * 4; *(LAS f32x4*)(sm + r * 68 + c) = *(const f32x4*)(src + (size_t)r * N + c); }
        __syncthreads();
        const int n = tid & 63, kc = tid >> 6;
        unsigned w[8];
#pragma unroll
        for (int i = 0; i < 8; ++i) w[i] = cvtpk(sm[(kc * 16 + 2 * i) * 68 + n], sm[(kc * 16 + 2 * i + 1) * 68 + n]);
        bf16_t* dst = Wt + (size_t)mat * N * D + (size_t)(tn * 64 + n) * D + tk * 128 + kc * 16;
        *(u32x4*)dst = (u32x4){w[0], w[1], w[2], w[3]}; *(u32x4*)(dst + 8) = (u32x4){w[4], w[5], w[6], w[7]};
    }
    __syncthreads();
}
__device__ __forceinline__ void convert_bf16(const float* src, bf16_t* dst, size_t n) {
    const size_t stride = (size_t)gridDim.x * NTHR * 8;
    const int tid = ltid();
    for (size_t i = ((size_t)blockIdx.x * NTHR + tid) * 8; i < n; i += stride) {
        const f32x4 a = __builtin_nontemporal_load((const f32x4*)(src + i)), b = __builtin_nontemporal_load((const f32x4*)(src + i + 4));
        u32x4 w; w.x = cvtpk(a[0], a[1]); w.y = cvtpk(a[2], a[3]); w.z = cvtpk(b[0], b[1]); w.w = cvtpk(b[2], b[3]);
        __builtin_nontemporal_store(w, (u32x4*)(dst + i));
    }
}
__device__ __forceinline__ void rope_table(float* cosT, float* sinT) {
    const int tid = ltid();
    for (int i = blockIdx.x * NTHR + tid; i < SEQ * 64; i += gridDim.x * NTHR) {
        const int pos = i >> 6, d = i & 63;
        const float inv = (float)pow(10000.0, -(double)d / 64.0);
        const float ang = (float)pos * inv;
        cosT[i] = (float)cos((double)ang); sinT[i] = (float)sin((double)ang);
    }
}


namespace att {
constexpr int KBUF = 32768, VBUF = 32768, LV0 = 65536;
__device__ __forceinline__ int swap23(int k) { return (k & ~0xC) | ((k & 4) << 1) | ((k & 8) >> 1); }
__device__ __forceinline__ int v_rd_base(int lane) { return ((lane & 3) << 3) | (((lane >> 2) & 3) << 6) | (((lane >> 4) & 1) << 5) | (((lane >> 5) & 1) << 8); }
constexpr int v_rd_off(int d0, int ks, int half) { return d0 * 512 + ks * 8192 + half * 4096; }
__device__ __forceinline__ int crow(int r, int hi) { return (r & 3) + 8 * (r >> 2) + 4 * hi; }
#define SBAR() __builtin_amdgcn_sched_barrier(0)
#define WGBAR() do { asm volatile("" ::: "memory"); __builtin_amdgcn_s_barrier(); asm volatile("" ::: "memory"); } while (0)
#define GLDS(gp, lp) __builtin_amdgcn_global_load_lds((const unsigned*)(gp), (LAS unsigned*)(lp), 16, 0, 0)
#define PK4(P, B_, OUT) do { unsigned a0 = cvtpk(P[B_+0], P[B_+1]), a1 = cvtpk(P[B_+2], P[B_+3]);                          \
        unsigned b0 = cvtpk(P[B_+4], P[B_+5]), b1 = cvtpk(P[B_+6], P[B_+7]);                                             \
        auto r0 = __builtin_amdgcn_permlane32_swap(a0, b0, false, false); auto r1 = __builtin_amdgcn_permlane32_swap(a1, b1, false, false); \
        u32x4 w = {r0[0], r1[0], r0[1], r1[1]}; OUT = *reinterpret_cast<bf16x8*>(&w); } while (0)
#define TRRD(dst, addr, off) asm volatile("ds_read_b64_tr_b16 %0, %1 offset:%2" : "=&v"(dst) : "v"(addr), "i"(off) : "memory")
#define PV_DECL() s16x4 Al0, Al1, Al2, Al3, Ah0, Ah1, Ah2, Ah3, Bl0, Bl1, Bl2, Bl3, Bh0, Bh1, Bh2, Bh3
#define PV_LOAD(S_, vb, d0) do { constexpr int b_ = v_rd_off(d0, 0, 0);   \
        TRRD(S_##l0, vb, b_); TRRD(S_##h0, vb, b_ + 4096); TRRD(S_##l1, vb, b_ + 8192); TRRD(S_##h1, vb, b_ + 12288); \
        TRRD(S_##l2, vb, b_ + 16384); TRRD(S_##h2, vb, b_ + 20480); TRRD(S_##l3, vb, b_ + 24576); TRRD(S_##h3, vb, b_ + 28672); } while (0)
#define PV_MMA(o_, S_) do {             \
        o_ = __builtin_amdgcn_mfma_f32_32x32x16_bf16(pa0, (bf16x8){S_##l0[0], S_##l0[1], S_##l0[2], S_##l0[3], S_##h0[0], S_##h0[1], S_##h0[2], S_##h0[3]}, o_, 0, 0, 0);   \
        o_ = __builtin_amdgcn_mfma_f32_32x32x16_bf16(pa1, (bf16x8){S_##l1[0], S_##l1[1], S_##l1[2], S_##l1[3], S_##h1[0], S_##h1[1], S_##h1[2], S_##h1[3]}, o_, 0, 0, 0);   \
        o_ = __builtin_amdgcn_mfma_f32_32x32x16_bf16(pa2, (bf16x8){S_##l2[0], S_##l2[1], S_##l2[2], S_##l2[3], S_##h2[0], S_##h2[1], S_##h2[2], S_##h2[3]}, o_, 0, 0, 0);   \
        o_ = __builtin_amdgcn_mfma_f32_32x32x16_bf16(pa3, (bf16x8){S_##l3[0], S_##l3[1], S_##l3[2], S_##l3[3], S_##h3[0], S_##h3[1], S_##h3[2], S_##h3[3]}, o_, 0, 0, 0); } while (0)
#define LGKM(n) do { asm volatile("s_waitcnt lgkmcnt(" #n ")" ::: "memory"); SBAR(); } while (0)
struct KVSrc { const char* k0; const char* k1; unsigned vd0, vd1; int stride0, stride1, nsplit; };
__device__ __forceinline__ void kv_tile(const KVSrc& s, int j, const char*& kt, const char*& vt, int& strideB) {
    const bool first = j < s.nsplit;
    strideB = first ? s.stride0 : s.stride1;
    const size_t off = (size_t)(first ? j : j - s.nsplit) * 64 * strideB;
    kt = (first ? s.k0 : s.k1) + off; vt = kt + (first ? s.vd0 : s.vd1);
}
__device__ __forceinline__ void issue_V(LAS unsigned char* lds, int buf, const char* vt, int strideB, int wid, int lane) {
    const int kV = swap23(8 * wid + ((lane & 31) >> 2));
    const char* src = vt + (size_t)kV * strideB + (lane >> 5) * 64 + (lane & 3) * 16;
    LAS unsigned char* dst = lds + LV0 + buf * VBUF + wid * 4096;
#pragma unroll
    for (int jj = 0; jj < 4; ++jj) GLDS(src + jj * 128, dst + jj * 1024);
}

struct DItem { const bf16_t* q; KVSrc kv; int nt_lo, nt_hi; bf16_t* o; };
__device__ __forceinline__ void issue_K2(LAS unsigned char* lds, int buf, const char* kt, int strideB, int wid, int lane) {
    const int map = wid >> 2, jrow = wid & 3, rowL = 4 * jrow + (lane >> 4);
    const char* src = kt + (size_t)rowL * strideB + map * 256 + (((lane & 15) ^ rowL) << 4);
    LAS unsigned char* dst = lds + buf * KBUF + map * 16384 + jrow * 1024;
#pragma unroll
    for (int jj = 0; jj < 4; ++jj) GLDS(src + (size_t)jj * 16 * strideB, dst + jj * 4096);
}
struct Dma { const char* src; LAS unsigned char* dst; int sstep, dstep; };
__device__ __forceinline__ Dma dma_K2(LAS unsigned char* lds, int buf, const char* kt, int strideB, int wid, int lane) {
    const int map = wid >> 2, jrow = wid & 3, rowL = 4 * jrow + (lane >> 4);
    Dma d; d.src = kt + (size_t)rowL * strideB + map * 256 + (((lane & 15) ^ rowL) << 4); d.dst = lds + buf * KBUF + map * 16384 + jrow * 1024; d.sstep = 16 * strideB; d.dstep = 4096; return d; }
__device__ __forceinline__ Dma dma_V(LAS unsigned char* lds, int buf, const char* vt, int strideB, int wid, int lane) {
    const int kV = swap23(8 * wid + ((lane & 31) >> 2));
    Dma d; d.src = vt + (size_t)kV * strideB + (lane >> 5) * 64 + (lane & 3) * 16; d.dst = lds + LV0 + buf * VBUF + wid * 4096; d.sstep = 128; d.dstep = 1024; return d; }
#define DMA_PIECE(d_, jj) GLDS((d_).src + (size_t)(jj) * (d_).sstep, (d_).dst + (jj) * (d_).dstep)
constexpr float DSCALE = 0.08838834764831845f, DC2 = 1.4426950408889634f * DSCALE, DTHR = 6.f;

__device__ __forceinline__ void diff_item(const DItem& it, LAS unsigned char* lds, float lam, float post, const float* subw) {
    int tid = threadIdx.x; asm volatile("" : "+v"(tid));
    const int wid = __builtin_amdgcn_readfirstlane(tid >> 6), lane = tid & 63, r32 = lane & 31, hi = lane >> 5;
    const int grp = wid >> 2, wq = wid & 3;
    const int ntw = (wq < 2) ? it.nt_lo : it.nt_hi, NT = it.nt_lo > it.nt_hi ? it.nt_lo : it.nt_hi;
    LAS float* ws = (LAS float*)(lds + LDS_SCR) + wid * 64; LAS float* li_l = ws; LAS float* al_l = ws + 32;
    bf16x8 qr[8];
    if (ntw > 0) { const bf16_t* qp = it.q + (size_t)(wq * 32 + r32) * NIN + grp * 128 + hi * 8;
#pragma unroll
        for (int d0 = 0; d0 < 8; ++d0) qr[d0] = *(const bf16x8*)(qp + d0 * 16); }
    else {
#pragma unroll
        for (int d0 = 0; d0 < 8; ++d0) qr[d0] = (bf16x8){0, 0, 0, 0, 0, 0, 0, 0}; }
    f32x16 o[8];
#pragma unroll
    for (int d0 = 0; d0 < 8; ++d0) o[d0] = f32x16{};
    float m_reg = -1e30f, l_reg = 0.f;
    bf16x8 pa0 = {}, pa1 = {}, pa2 = {}, pa3 = {};
    const int xh = (r32 >> 1) & 7;
    LAS unsigned char* krd = lds + grp * 16384 + r32 * 256 + ((hi ^ (r32 & 1)) << 4);
    const int vb0 = (int)(uintptr_t)(lds + LV0) + v_rd_base(lane);
    const char* kt; const char* vt; int sB;
#define ISSUE_K(t_) do { kv_tile(it.kv, (t_), kt, vt, sB); issue_K2(lds, (t_) & 1, kt, sB, wid, lane); } while (0)
#define ISSUE_V(t_) do { kv_tile(it.kv, (t_), kt, vt, sB); issue_V(lds, (t_) & 1, vt, sB, wid, lane); } while (0)
#define WAIT_BAR(issued) do { if (issued) asm volatile("s_waitcnt vmcnt(4)" ::: "memory"); else asm volatile("s_waitcnt vmcnt(0)" ::: "memory"); WGBAR(); } while (0)
    ISSUE_K(0); ISSUE_V(0);
    asm volatile("s_waitcnt vmcnt(0)" ::: "memory"); WGBAR();
    if (grp == 1) { const bool is = 1 < NT; if (is) ISSUE_K(1); WAIT_BAR(is); }
    for (int t = 0; t < NT; ++t) {
        const bool isx = t + 1 < NT;
        Dma dx; dx.src = nullptr; dx.dst = lds; dx.sstep = 0; dx.dstep = 0;
        if (isx) { kv_tile(it.kv, t + 1, kt, vt, sB); dx = (grp == 0) ? dma_K2(lds, (t + 1) & 1, kt, sB, wid, lane) : dma_V(lds, (t + 1) & 1, vt, sB, wid, lane); }
        if (t >= ntw && isx) { DMA_PIECE(dx, 0); DMA_PIECE(dx, 1); DMA_PIECE(dx, 2); DMA_PIECE(dx, 3); }
        if (t < ntw) {
            f32x16 p0 = f32x16{}, p1 = f32x16{};
            LAS unsigned char* kb = krd + (t & 1) * KBUF;
            __builtin_amdgcn_s_setprio(2);
            {
                const int kbv = (int)(uintptr_t)kb;
                bf16x8 KA0, KA1, KB0, KB1;
#define KRD2(S_, d0) do { const int a_ = kbv + ((((d0) ^ xh)) << 5); asm volatile("ds_read_b128 %0, %2\n\tds_read_b128 %1, %2 offset:8192" : "=&v"(S_##0), "=&v"(S_##1) : "v"(a_) : "memory"); } while (0)
#define QKMMA(S_, d0) do { p0 = __builtin_amdgcn_mfma_f32_32x32x16_bf16(S_##0, qr[d0], p0, 0, 0, 0); p1 = __builtin_amdgcn_mfma_f32_32x32x16_bf16(S_##1, qr[d0], p1, 0, 0, 0); } while (0)
                KRD2(KA, 0);
                KRD2(KB, 1); LGKM(2); QKMMA(KA, 0);
                KRD2(KA, 2); LGKM(2); QKMMA(KB, 1); if (isx) DMA_PIECE(dx, 0);
                KRD2(KB, 3); LGKM(2); QKMMA(KA, 2);
                KRD2(KA, 4); LGKM(2); QKMMA(KB, 3); if (isx) DMA_PIECE(dx, 1);
                KRD2(KB, 5); LGKM(2); QKMMA(KA, 4);
                KRD2(KA, 6); LGKM(2); QKMMA(KB, 5); if (isx) DMA_PIECE(dx, 2);
                KRD2(KB, 7); LGKM(2); QKMMA(KA, 6);
                LGKM(0); QKMMA(KB, 7); if (isx) DMA_PIECE(dx, 3);
#undef KRD2
#undef QKMMA
            }
            __builtin_amdgcn_s_setprio(0);
            float pmax = p0[0];
#pragma unroll
            for (int r = 1; r < 16; ++r) pmax = fmaxf(pmax, p0[r]);
#pragma unroll
            for (int r = 0; r < 16; ++r) pmax = fmaxf(pmax, p1[r]);
            { auto rr = __builtin_amdgcn_permlane32_swap(__float_as_uint(pmax), __float_as_uint(pmax), false, false);
              pmax = fmaxf(__uint_as_float(rr[0]), __uint_as_float(rr[1])); }
            float mn, alpha;
            if (__builtin_expect(__all((pmax - m_reg) * DSCALE <= DTHR), 1)) { mn = m_reg; alpha = 1.f; }
            else { mn = fmaxf(m_reg, pmax); alpha = __builtin_amdgcn_exp2f((m_reg - mn) * DC2); m_reg = mn; }
            const float mnL = -mn * DC2;
            float ps = 0.f;
#pragma unroll
            for (int r = 0; r < 16; ++r) { p0[r] = __builtin_amdgcn_exp2f(fmaf(p0[r], DC2, mnL)); ps += p0[r]; }
#pragma unroll
            for (int r = 0; r < 16; ++r) { p1[r] = __builtin_amdgcn_exp2f(fmaf(p1[r], DC2, mnL)); ps += p1[r]; }
            { auto rr = __builtin_amdgcn_permlane32_swap(__float_as_uint(ps), __float_as_uint(ps), false, false);
              ps = __uint_as_float(rr[0]) + __uint_as_float(rr[1]); }
            l_reg = l_reg * alpha + ps;
            PK4(p0, 0, pa0); PK4(p0, 8, pa1); PK4(p1, 0, pa2); PK4(p1, 8, pa3);
            if (__any(alpha < 1.f)) {
                if (hi == 0) al_l[r32] = alpha;
                asm volatile("s_waitcnt lgkmcnt(0)" ::: "memory");
#pragma unroll
                for (int r = 0; r < 16; ++r) { const float a = al_l[crow(r, hi)];
#pragma unroll
                    for (int d0 = 0; d0 < 8; ++d0) o[d0][r] *= a; }
            }
        }
        WAIT_BAR(isx);
        const bool isy = (grp == 0) ? (t + 1 < NT) : (t + 2 < NT);
        Dma dy; dy.src = nullptr; dy.dst = lds; dy.sstep = 0; dy.dstep = 0;
        if (isy) { if (grp == 0) { kv_tile(it.kv, t + 1, kt, vt, sB); dy = dma_V(lds, (t + 1) & 1, vt, sB, wid, lane); } else { kv_tile(it.kv, t + 2, kt, vt, sB); dy = dma_K2(lds, t & 1, kt, sB, wid, lane); } }
        if (t >= ntw && isy) { DMA_PIECE(dy, 0); DMA_PIECE(dy, 1); DMA_PIECE(dy, 2); DMA_PIECE(dy, 3); }
        if (t < ntw) {
            const int vb = vb0 + (t & 1) * VBUF;
            __builtin_amdgcn_s_setprio(1);
            PV_DECL();
            PV_LOAD(A, vb, 0);
            PV_LOAD(B, vb, 1); LGKM(8); PV_MMA(o[0], A); if (isy) DMA_PIECE(dy, 0);
            PV_LOAD(A, vb, 2); LGKM(8); PV_MMA(o[1], B);
            PV_LOAD(B, vb, 3); LGKM(8); PV_MMA(o[2], A); if (isy) DMA_PIECE(dy, 1);
            PV_LOAD(A, vb, 4); LGKM(8); PV_MMA(o[3], B);
            PV_LOAD(B, vb, 5); LGKM(8); PV_MMA(o[4], A); if (isy) DMA_PIECE(dy, 2);
            PV_LOAD(A, vb, 6); LGKM(8); PV_MMA(o[5], B);
            PV_LOAD(B, vb, 7); LGKM(8); PV_MMA(o[6], A); if (isy) DMA_PIECE(dy, 3);
            LGKM(0); PV_MMA(o[7], B);
            __builtin_amdgcn_s_setprio(0);
        }
        WAIT_BAR(isy);
    }
    if (grp == 0) WGBAR();
#undef ISSUE_K
#undef ISSUE_V
    const bool active = ntw > 0;
    if (active) {
        if (hi == 0) li_l[r32] = (grp == 0 ? 1.f : -lam) / l_reg;
        asm volatile("s_waitcnt lgkmcnt(0)" ::: "memory");
#pragma unroll
        for (int r = 0; r < 16; ++r) { const float a = li_l[crow(r, hi)];
#pragma unroll
            for (int d0 = 0; d0 < 8; ++d0) o[d0][r] *= a; }
        if (grp == 1) {
#pragma unroll
            for (int r = 0; r < 16; ++r) { LAS float* xp = (LAS float*)(lds + (wq * 32 + crow(r, hi)) * 1024) + r32;
#pragma unroll
                for (int d0 = 0; d0 < 8; ++d0) xp[d0 * 32] = o[d0][r]; }
        }
    }
    asm volatile("s_waitcnt lgkmcnt(0)" ::: "memory"); WGBAR();
    if (active && grp == 0) {
        float sw[8];
#pragma unroll
        for (int d0 = 0; d0 < 8; ++d0) sw[d0] = subw[d0 * 32 + r32] * post;
#pragma unroll
        for (int r = 0; r < 16; ++r) {
            const int row = wq * 32 + crow(r, hi);
            LAS float* xp = (LAS float*)(lds + row * 1024) + r32;
            float ssq = 0.f;
#pragma unroll
            for (int d0 = 0; d0 < 8; ++d0) { o[d0][r] += xp[d0 * 32]; ssq += o[d0][r] * o[d0][r]; }
            ssq = half_sum(ssq);
            const float rs = 1.0f / sqrtf(ssq * (1.0f / 256.0f) + EPS);
            const bf16_t* gp = it.q + 3072 + (size_t)row * NIN + r32;
            bf16_t* op = it.o + (size_t)row * D + r32;
#pragma unroll
            for (int d0 = 0; d0 < 8; ++d0) {
                const float gv = bf2f(gp[d0 * 32]);
                const float val = o[d0][r] * rs * sw[d0] * gv / (1.0f + __expf(-gv));
                const float vn = xor_lane<1>(val);
                if ((r32 & 1) == 0) *(unsigned*)(op + d0 * 32) = cvtpk(val, vn);
            }
        }
    }
    asm volatile("s_waitcnt vmcnt(0) lgkmcnt(0)" ::: "memory"); WGBAR();
}

struct SItem { const bf16_t* q; KVSrc kv; int P0, nrows, jstart; bf16_t* o; };
__device__ __forceinline__ void issue_K1(LAS unsigned char* lds, int buf, const char* kt, int strideB, int wid, int lane) {
    const int rowL = 2 * wid + (lane >> 5);
    const char* src = kt + (size_t)rowL * strideB + (((lane & 31) ^ rowL) << 4);
    LAS unsigned char* dst = lds + buf * KBUF + wid * 1024;
#pragma unroll
    for (int jj = 0; jj < 4; ++jj) GLDS(src + (size_t)jj * 16 * strideB, dst + jj * 8192);
}
constexpr float LOG2E = 1.4426950408889634f, LN2 = 0.6931471805599453f;

#define SB_HALF(HALF_, PA, PB) do {                                                                                                                   \
        f32x16 z = f32x16{};                                                                                                                        \
        _Pragma("unroll") for (int d0 = 0; d0 < 16; ++d0) { const bf16x8 kf = *(const LAS bf16x8*)(kb + ((d0 ^ xh) << 5) + (HALF_) * 16384);         \
            z = __builtin_amdgcn_mfma_f32_32x32x16_bf16(kf, qr[d0], z, 0, 0, 0); }                                                                  \
        float L[16];                                                                                                                                \
        _Pragma("unroll") for (int r = 0; r < 16; ++r) { const float t_ = __builtin_amdgcn_exp2f(-fabsf(z[r]) * LOG2E);                               \
            L[r] = -(fmaxf(z[r], 0.f) + LN2 * __builtin_amdgcn_logf(1.0f + t_));                                                                    \
            if (diag && (32 * (HALF_) + crow(r, hi)) >= lim) L[r] = 0.f; }                                                                           \
        float Te[4], To[4];                                                                                                                         \
        _Pragma("unroll") for (int i = 0; i < 4; ++i) { L[4 * i + 2] += L[4 * i + 3]; L[4 * i + 1] += L[4 * i + 2]; L[4 * i] += L[4 * i + 1];       \
            auto rr = __builtin_amdgcn_permlane32_swap(__float_as_uint(L[4 * i]), __float_as_uint(L[4 * i]), false, false);                          \
            Te[i] = __uint_as_float(rr[0]); To[i] = __uint_as_float(rr[1]); }                                                                        \
        float run = C;                                                                                                                              \
        _Pragma("unroll") for (int i = 3; i >= 0; --i) { const float eo = run; run += To[i]; const float ee = run; run += Te[i];                    \
            const float off = hi ? eo : ee;                                                                                                         \
            _Pragma("unroll") for (int e = 0; e < 4; ++e) { const int r = 4 * i + e;                                                                  \
                float a = __builtin_amdgcn_exp2f((z[r] + L[r] + off) * LOG2E);                                                                      \
                if (diag && (32 * (HALF_) + crow(r, hi)) >= lim) a = 0.f;                                                                            \
                z[r] = a; } }                                                                                                                       \
        C = run;                                                                                                                                    \
        PK4(z, 0, PA); PK4(z, 8, PB);                                                                                                               \
    } while (0)

__device__ __forceinline__ void sb_item(const SItem& it, LAS unsigned char* lds) {
    int tid = threadIdx.x; asm volatile("" : "+v"(tid));
    const int wid = __builtin_amdgcn_readfirstlane(tid >> 6), lane = tid & 63, r32 = lane & 31, hi = lane >> 5;
    const int dh = wid >> 2, wq = wid & 3;
    const bool active = wq * 32 < it.nrows;
    volatile LAS unsigned* flags = (volatile LAS unsigned*)(lds + LDS_MISC + 64);
    bf16x8 qr[16];
    if (active) { const bf16_t* qp = it.q + (size_t)(wq * 32 + r32) * NIN + hi * 8;
#pragma unroll
        for (int d0 = 0; d0 < 16; ++d0) qr[d0] = *(const bf16x8*)(qp + d0 * 16); }
    else {
#pragma unroll
        for (int d0 = 0; d0 < 16; ++d0) qr[d0] = (bf16x8){0, 0, 0, 0, 0, 0, 0, 0}; }
    f32x16 o[4];
#pragma unroll
    for (int dd = 0; dd < 4; ++dd) o[dd] = f32x16{};
    float C = 0.f;
    const int P0w = it.P0 + 32 * wq, jw = P0w >> 6, lim = (P0w & 63) + r32;
    const int xh = (r32 >> 1) & 7;
    LAS unsigned char* krd = lds + r32 * 512 + ((hi ^ (r32 & 1)) << 4);
    const int vb0 = (int)(uintptr_t)(lds + LV0) + v_rd_base(lane) + dh * 4 * 512;
    const char* kt; const char* vt; int sB;
    bool done = !active;
    kv_tile(it.kv, it.jstart, kt, vt, sB); issue_K1(lds, 0, kt, sB, wid, lane); issue_V(lds, 0, vt, sB, wid, lane);
    asm volatile("s_waitcnt vmcnt(0)" ::: "memory"); WGBAR();
    for (int itn = 0;; ++itn) {
        const int j = it.jstart - itn, b = itn & 1;
        if (j > 0) { kv_tile(it.kv, j - 1, kt, vt, sB); issue_K1(lds, b ^ 1, kt, sB, wid, lane); issue_V(lds, b ^ 1, vt, sB, wid, lane); }
        if (!done && j <= jw) {
            const bool diag = (j == jw);
            LAS unsigned char* kb = krd + b * KBUF;
            bf16x8 pa0, pa1, pa2, pa3;
            SB_HALF(1, pa2, pa3);
            SB_HALF(0, pa0, pa1);
            const int vb = vb0 + b * VBUF;
            PV_DECL();
            PV_LOAD(A, vb, 0);
            PV_LOAD(B, vb, 1); LGKM(8); PV_MMA(o[0], A);
            PV_LOAD(A, vb, 2); LGKM(8); PV_MMA(o[1], B);
            PV_LOAD(B, vb, 3); LGKM(8); PV_MMA(o[2], A);
            LGKM(0); PV_MMA(o[3], B);
            if (__all(C <= -104.f)) done = true;
        }
        if (lane == 0) flags[b * 8 + wid] = done ? 1u : 0u;
        asm volatile("s_waitcnt vmcnt(0) lgkmcnt(0)" ::: "memory"); WGBAR();
        if (j == 0) break;
        const unsigned f = (lane < 8) ? flags[b * 8 + lane] : 1u;
        if (!__any(f == 0u)) break;
    }
    asm volatile("s_waitcnt vmcnt(0) lgkmcnt(0)" ::: "memory"); WGBAR();
    if (active) {
#pragma unroll
        for (int r = 0; r < 16; ++r) {
            const int row = wq * 32 + crow(r, hi);
            const bf16_t* gp = it.q + 3072 + (size_t)row * NIN + dh * 128 + r32;
            bf16_t* op = it.o + (size_t)row * D + dh * 128 + r32;
#pragma unroll
            for (int dd = 0; dd < 4; ++dd) {
                const float gv = bf2f(gp[dd * 32]);
                const float val = o[dd][r] * gv / (1.0f + __expf(-gv));
                const float vn = xor_lane<1>(val);
                if ((r32 & 1) == 0) *(unsigned*)(op + dd * 32) = cvtpk(val, vn);
            }
        }
    }
}
}

struct DSched { unsigned char it[32][8]; unsigned char n[32]; };
constexpr DSched make_dsched() {
    DSched s{}; int load[32] = {};
    for (int i = 0; i < 32; ++i) { s.n[i] = 0; for (int k = 0; k < 8; ++k) s.it[i][k] = 0; }
    for (int step = 0; step < 136; ++step) {
        int code, cost;
        if (step < 112) { code = 127 - step; cost = 2 * code + 2; }
        else if (step < 120) { code = 128 + (step - 112); cost = 33; }
        else { code = 15 - (step - 120); cost = 2 * code + 2; }
        int best = 0;
        for (int i = 1; i < 32; ++i) if (load[i] < load[best]) best = i;
        s.it[best][s.n[best]] = (unsigned char)code; s.n[best] = (unsigned char)(s.n[best] + 1); load[best] += cost;
    }
    return s;
}
__device__ const DSched g_dsched = make_dsched();

#define CAS __attribute__((address_space(4)))
#define KARGS() const CAS unsigned char* kp_ = (const CAS unsigned char*)__builtin_amdgcn_kernarg_segment_ptr(); asm volatile("" : "+s"(kp_))
#define KIN(i) as_global(*(const float* const CAS*)(kp_ + 8 * (i)))
#define KOUT() as_global(*(float* const CAS*)(kp_ + 80))
#define KWS() as_global(*(unsigned char* const CAS*)(kp_ + 88))
__global__ void __launch_bounds__(NTHR, 2) fwd(const float* in0, const float* in1, const float* in2, const float* in3, const float* in4, const float* in5, const float* in6,
                                               const float* in7, const float* in8, const float* in9, float* out_, unsigned char* ws_, int ph_lo, int ph_hi) {
    extern __shared__ __attribute__((aligned(16))) unsigned char lds_raw[];
    LAS unsigned char* lds = (LAS unsigned char*)lds_raw;
    const int G = gridDim.x, bx = blockIdx.x;
    volatile LAS unsigned* misc = (volatile LAS unsigned*)(lds + LDS_MISC);
    if (threadIdx.x < 64) misc[threadIdx.x] = 0u;
    __syncthreads();
    XcdBarrier bar; bar.x = 0; bar.st = misc;
    { KARGS(); bar.bar = (unsigned*)(KWS() + WS_CTL) + CW_BAR; }
    if (!MK_PER_PHASE) bar = xcd_barrier_post(bar.bar, misc);
#define GRID_BAR() do { if (!MK_PER_PHASE) xcd_barrier(bar); } while (0)
    int lo, hi_; { KARGS(); lo = *(const int CAS*)(kp_ + 96); hi_ = *(const int CAS*)(kp_ + 100); }
#define IN(k) (lo <= (k) && (k) < hi_)
#define PHASE_PTRS() \
    KARGS(); unsigned char* ws = KWS(); \
    unsigned* ctl = (unsigned*)(ws + WS_CTL); (void)ctl; \
    bf16_t* H = (bf16_t*)(ws + WS_H); bf16_t* QKVG = (bf16_t*)(ws + WS_QKVG); float* Y = (float*)(ws + WS_Y); (void)H; (void)QKVG; (void)Y; \
    float* out = KOUT(); (void)out;
    if (IN(0)) {
        PHASE_PTRS();
        transpose_weights(KIN(5), (bf16_t*)(ws + WS_WIN), NIN, DEPTH, (LAS float*)lds);
        transpose_weights(KIN(6), (bf16_t*)(ws + WS_WOUT), D, DEPTH, (LAS float*)lds);
        rope_table((float*)(ws + WS_COS), (float*)(ws + WS_SIN));
        convert_bf16(KIN(2), (bf16_t*)(ws + WS_CK), (size_t)DEPTH * DBATCH * PAST * D);
        convert_bf16(KIN(3), (bf16_t*)(ws + WS_CV), (size_t)DEPTH * DBATCH * PAST * D);
        norm_phase(KIN(0), KIN(1) - (size_t)MP * D, KIN(4), H, nullptr, nullptr, 0);
        GRID_BAR();
    }
    for (int l = 0; l < DEPTH; ++l) {
        const int pb = 1 + 4 * l;
        const bool even = (l & 1) == 0;
        if (IN(pb)) {
            PHASE_PTRS();
            bf16_t* WIN = (bf16_t*)(ws + WS_WIN); float* COS = (float*)(ws + WS_COS);
            pg8::Gemm g{H, WIN + (size_t)l * NIN * D}; int bxl = bx; asm volatile("" : "+s"(bxl)); pg8::StaticOrder<MTOT, NIN> S; S.init(G, bxl);
            EpiIn E{QKVG, out, COS, l};
#ifndef NO_GIN
            pg8::gemm_phase<EpiIn, MTOT, NIN, D>(lds, g, S, E);
#endif
            GRID_BAR();
        }
        if (IN(pb + 1)) {
            PHASE_PTRS();
            bf16_t* CK = (bf16_t*)(ws + WS_CK);
            if (even) {
                const int lane = ltid() & 63;
                const float* lf = KIN(7) + (size_t)(l >> 1) * 4 * 128;
                const float s1 = wave_sum(lf[lane] * lf[128 + lane] + lf[64 + lane] * lf[192 + lane]);
                const float s2 = wave_sum(lf[256 + lane] * lf[384 + lane] + lf[320 + lane] * lf[448 + lane]);
                const float lam_init = (l == 0) ? 0.2f : 0.47071301834358406f;
                const float lam = __int_as_float(__builtin_amdgcn_readfirstlane(__float_as_int(__expf(s1) - __expf(s2) + lam_init)));
                const float* subw = KIN(8) + (size_t)(l >> 1) * 256;
                const bool tab = (G == 256);
                const int nitems = tab ? (int)g_dsched.n[bx >> 3] : (1088 - bx + G - 1) / G;
                for (int k = 0; k < nitems; ++k) {
                    int bh, code;
                    if (tab) { bh = bx & 7; code = g_dsched.it[bx >> 3][k]; }
                    else { const int id = bx + k * G; if (id < 1024) { bh = id & 7; code = id >> 3; } else { bh = (id - 1024) >> 3; code = 128 + ((id - 1024) & 7); } }
                    const bool pr = code < 128;
                    const int x = code, s = bh * 8 + (code - 128);
                    const int b = bh >> 2, h = pr ? (bh & 3) : (s & 3), sb = s >> 2;
                    const size_t row0 = pr ? (size_t)b * SEQ + (size_t)x * 128 : (size_t)MP + (size_t)sb * DSEQ;
                    const size_t krow = pr ? (size_t)b * SEQ : row0;
                    const bf16_t* knew = QKVG + krow * NIN + 1024 + h * 256;
                    const size_t coff = ((size_t)(l * DBATCH + sb) * PAST) * D + h * 256;
                    att::DItem it;
                    it.q = QKVG + row0 * NIN + h * 256;
                    it.kv.k1 = (const char*)knew; it.kv.vd1 = 2048u; it.kv.stride1 = NIN * 2;
                    it.kv.k0 = pr ? (const char*)knew : (const char*)(CK + coff); it.kv.vd0 = pr ? 2048u : (unsigned)(WS_CV - WS_CK);
                    it.kv.stride0 = pr ? NIN * 2 : D * 2; it.kv.nsplit = pr ? (1 << 30) : PAST / 64;
                    it.nt_lo = pr ? 2 * x + 1 : PAST / 64 + 1; it.nt_hi = pr ? 2 * x + 2 : 0;
                    it.o = H + row0 * D + h * 256;
#ifndef NO_DIFF
                    att::diff_item(it, lds, lam, 1.0f - lam_init, subw);
#endif
                }
            } else {
                for (int id = bx; id < 1088; id += G) {
                    const bool pr = id < 1024;
                    const int bh = id & 7, x = id >> 3, s = id - 1024;
                    const int b = bh >> 2, h = pr ? (bh & 3) : (s & 3), sb = s >> 2;
                    const size_t row0 = pr ? (size_t)b * SEQ + (size_t)x * 128 : (size_t)MP + (size_t)sb * DSEQ;
                    const size_t krow = pr ? (size_t)b * SEQ : row0;
                    const bf16_t* knew = QKVG + krow * NIN + 1024 + h * 256;
                    const size_t coff = ((size_t)(l * DBATCH + sb) * PAST) * D + h * 256;
                    att::SItem it;
                    it.q = QKVG + row0 * NIN + h * 256;
                    it.kv.k1 = (const char*)knew; it.kv.vd1 = 2048u; it.kv.stride1 = NIN * 2;
                    it.kv.k0 = pr ? (const char*)knew : (const char*)(CK + coff); it.kv.vd0 = pr ? 2048u : (unsigned)(WS_CV - WS_CK);
                    it.kv.stride0 = pr ? NIN * 2 : D * 2; it.kv.nsplit = pr ? (1 << 30) : PAST / 64;
                    it.P0 = pr ? x * 128 : PAST; it.nrows = pr ? 128 : DSEQ; it.jstart = pr ? 2 * x + 1 : PAST / 64;
                    it.o = H + row0 * D + h * 256;
#ifndef NO_SB
                    att::sb_item(it, lds);
#endif
                }
            }
            GRID_BAR();
        }
        if (IN(pb + 2)) {
            PHASE_PTRS();
            bf16_t* WOUT = (bf16_t*)(ws + WS_WOUT);
            pg8::Gemm g{H, WOUT + (size_t)l * D * D}; int bxl = bx; asm volatile("" : "+s"(bxl)); pg8::StaticOrder<MTOT, D> S; S.init(G, bxl);
            EpiOut E{l == 0 ? KIN(0) : Y, l == 0 ? KIN(1) - (size_t)MP * D : Y, Y};
#ifndef NO_GOUT
            pg8::gemm_phase<EpiOut, MTOT, D, D>(lds, g, S, E);
#endif
            GRID_BAR();
        }
        if (IN(pb + 3)) {
            PHASE_PTRS();
            if (l < DEPTH - 1) { norm_phase(Y, Y, KIN(4) + (size_t)(l + 1) * D, H, nullptr, nullptr, 0); GRID_BAR(); }
            else norm_phase(Y, Y, KIN(9), nullptr, out + OY_P, out + OY_S - (size_t)MP * D, 1);
        }
    }
#undef IN
#undef GRID_BAR
}

extern "C" void kernel_launch(void* const* d_in, const int* in_sizes, int n_in, void* d_out, int out_size, void* d_ws, size_t ws_size, hipStream_t stream) {
    static int grid = 0;
    if (grid == 0) {
        if (n_in != 10 || (size_t)out_size != O_END || ws_size < WS_END) { fprintf(stderr, "kernel_launch: unexpected shapes (n_in %d out %d ws %zu, want 10 / %zu / >= %zu)\n", n_in, out_size, ws_size, (size_t)O_END, (size_t)WS_END); grid = -1; return; }
        int dev = 0, cus = 0, per_cu = 0;
        if (hipGetDevice(&dev) != hipSuccess || hipDeviceGetAttribute(&cus, hipDeviceAttributeMultiprocessorCount, dev) != hipSuccess) { grid = -1; return; }
        if (hipFuncSetAttribute((const void*)fwd, hipFuncAttributeMaxDynamicSharedMemorySize, LDS_BYTES) != hipSuccess) { fprintf(stderr, "kernel_launch: hipFuncSetAttribute failed\n"); grid = -1; return; }
        if (hipOccupancyMaxActiveBlocksPerMultiprocessor(&per_cu, (const void*)fwd, NTHR, LDS_BYTES) != hipSuccess || per_cu < 1) { fprintf(stderr, "kernel_launch: occupancy query says %d blocks per CU\n", per_cu); }
        (void)hipGetLastError();
        grid = cus;
    }
    if (grid < 0) return;
    (void)hipMemsetAsync((char*)d_ws + WS_CTL, 0, CTL_BYTES, stream);
    const float* in[10];
    for (int i = 0; i < 10; ++i) in[i] = (const float*)d_in[i];
#if MK_PER_PHASE
    for (int p = 0; p < 17; ++p) hipLaunchKernelGGL(fwd, dim3(grid), dim3(NTHR), LDS_BYTES, stream, in[0], in[1], in[2], in[3], in[4], in[5], in[6], in[7], in[8], in[9], (float*)d_out, (unsigned char*)d_ws, p, p + 1);
#else
    hipLaunchKernelGGL(fwd, dim3(grid), dim3(NTHR), LDS_BYTES, stream, in[0], in[1], in[2], in[3], in[4], in[5], in[6], in[7], in[8], in[9], (float*)d_out, (unsigned char*)d_ws, 0, 17);
#endif
}
```

```cpp
#include <hip/hip_runtime.h>
#include <cstdio>
#include <cstdint>

#ifndef MK_PER_PHASE
#define MK_PER_PHASE 0
#endif

constexpr int D = 1024, NBATCH = 2, SEQ = 16384, DEPTH = 4, DBATCH = 16, DSEQ = 64, PAST = 2048;
constexpr int MP = NBATCH * SEQ, MS = DBATCH * DSEQ, MTOT = MP + MS;
constexpr int NIN = 4 * D;
constexpr float EPS = 1e-6f;
constexpr size_t OY_P = 0, OY_S = OY_P + (size_t)MP * D, OK_P = OY_S + (size_t)MS * D, OV_P = OK_P + (size_t)DEPTH * MP * D,
                 OK_S = OV_P + (size_t)DEPTH * MP * D, OV_S = OK_S + (size_t)DEPTH * MS * D, O_END = OV_S + (size_t)DEPTH * MS * D;
constexpr size_t WS_CTL = 0, CTL_BYTES = 1048576;
constexpr size_t WS_WIN = WS_CTL + CTL_BYTES;
constexpr size_t WS_WOUT = WS_WIN + (size_t)DEPTH * NIN * D * 2;
constexpr size_t WS_COS = WS_WOUT + (size_t)DEPTH * D * D * 2;
constexpr size_t WS_SIN = WS_COS + (size_t)SEQ * 64 * 4;
constexpr size_t WS_H = WS_SIN + (size_t)SEQ * 64 * 4;
constexpr size_t WS_QKVG = WS_H + (size_t)MTOT * D * 2;
constexpr size_t WS_Y = WS_QKVG + (size_t)MTOT * NIN * 2;
constexpr size_t WS_CK = WS_Y + (size_t)MTOT * D * 4;
constexpr size_t WS_CV = WS_CK + (size_t)DEPTH * DBATCH * PAST * D * 2;
constexpr size_t WS_XB = WS_CV + (size_t)DEPTH * DBATCH * PAST * D * 2;
constexpr size_t WS_END = WS_XB + (size_t)MTOT * D * 2;
constexpr size_t CTL_SSQ = 65536;
constexpr int CW_BAR = 0;
constexpr int CW_KM = 4096;
constexpr int CW_TMO = 4096 + 256;

typedef unsigned short bf16_t;
typedef short bf16x8 __attribute__((ext_vector_type(8)));
typedef short s16x4 __attribute__((ext_vector_type(4)));
typedef float f32x16 __attribute__((ext_vector_type(16)));
typedef float f32x4 __attribute__((ext_vector_type(4)));
typedef float f32x2 __attribute__((ext_vector_type(2)));
typedef unsigned u32x4 __attribute__((ext_vector_type(4)));
typedef unsigned u32x2 __attribute__((ext_vector_type(2)));
#define LAS __attribute__((address_space(3)))
#define GAS __attribute__((address_space(1)))
template <class T> __device__ __forceinline__ T* as_global(T* p) { return (T*)(GAS T*)p; }

__device__ __forceinline__ unsigned cvtpk(float lo, float hi) { unsigned r; asm volatile("v_cvt_pk_bf16_f32 %0, %1, %2" : "=v"(r) : "v"(lo), "v"(hi)); return r; }
__device__ __forceinline__ float bf_lo(unsigned w) { return __uint_as_float(w << 16); }
__device__ __forceinline__ float bf_hi(unsigned w) { return __uint_as_float(w & 0xffff0000u); }
__device__ __forceinline__ float bf2f(bf16_t b) { return __uint_as_float(((unsigned)b) << 16); }
template <int M> __device__ __forceinline__ float xor_lane(float v) { return __int_as_float(__builtin_amdgcn_ds_swizzle(__float_as_int(v), (M << 10) | 0x1f)); }
__device__ __forceinline__ float wave_sum(float v) {
    v += xor_lane<1>(v); v += xor_lane<2>(v); v += xor_lane<4>(v); v += xor_lane<8>(v); v += xor_lane<16>(v);
    auto rr = __builtin_amdgcn_permlane32_swap(__float_as_uint(v), __float_as_uint(v), false, false); return __uint_as_float(rr[0]) + __uint_as_float(rr[1]); }
__device__ __forceinline__ float half_sum(float v) { v += xor_lane<1>(v); v += xor_lane<2>(v); v += xor_lane<4>(v); v += xor_lane<8>(v); v += xor_lane<16>(v); return v; }

#define XB_TMO      128
#define XB_XCNT(j)  (256  + 64 * (j))
#define XB_XSUB(j)  (1280 + 64 * (j))
#define XB_XGEN(j)  (2304 + 64 * (j))
#define XB_TOP      3328
#define XB_TOPGEN   3392
#define XCD_BAR_WORDS 3456
#define XB_SPIN_CAP (1u << 22)
__device__ __forceinline__ unsigned xb_ld(unsigned* p)              { return __hip_atomic_load(p, __ATOMIC_RELAXED, __HIP_MEMORY_SCOPE_AGENT); }
__device__ __forceinline__ unsigned xb_add(unsigned* p, unsigned v) { return __hip_atomic_fetch_add(p, v, __ATOMIC_RELAXED, __HIP_MEMORY_SCOPE_AGENT); }
__device__ __forceinline__ unsigned xb_xcc_id() { return (unsigned)__builtin_amdgcn_s_getreg((3 << 11) | 20) & 0xFu; }
#define XB_SPIN(cond, bar) do { unsigned _sp = 0; while (cond) { __builtin_amdgcn_s_sleep(1); \
    if ((++_sp & 255u) == 0u) { if (xb_ld(&(bar)[XB_TMO])) break; if (_sp > XB_SPIN_CAP) { atomicAdd(&(bar)[XB_TMO], 1u); break; } } } } while (0)
struct XcdBarrier { unsigned* bar; unsigned x; volatile LAS unsigned* st; };
__device__ __forceinline__ XcdBarrier xcd_barrier_post(unsigned* bar, volatile LAS unsigned* st) {
    XcdBarrier b; b.bar = bar; b.x = xb_xcc_id(); b.st = st;
    if (threadIdx.x == 0) (void)xb_add(&bar[XB_XCNT(b.x)], 1u);
    return b;
}
__device__ __forceinline__ void xcd_barrier_complete(unsigned* bar, unsigned x, unsigned& nloc, unsigned& nx) {
    const unsigned G = gridDim.x * gridDim.y * gridDim.z;
    unsigned sum, cnt, mine, sp = 0u;
    for (;;) {
        sum = 0u; cnt = 0u; mine = 0u;
#pragma unroll
        for (unsigned j = 0; j < 16; ++j) { const unsigned c = xb_ld(&bar[XB_XCNT(j)]); sum += c; cnt += (c > 0u) ? 1u : 0u; mine = (j == x) ? c : mine; }
        if (sum == G) break;
        __builtin_amdgcn_s_sleep(1);
        if ((++sp & 255u) == 0u) { if (xb_ld(&bar[XB_TMO])) break; if (sp > XB_SPIN_CAP) { atomicAdd(&bar[XB_TMO], 1u); break; } }
    }
    nloc = mine > 0u ? mine : 1u; nx = cnt > 0u ? cnt : 1u;
}
__device__ __forceinline__ void xcd_barrier(const XcdBarrier& b) {
    asm volatile("s_waitcnt vmcnt(0)" ::: "memory");
    __syncthreads();
    if (threadIdx.x == 0) {
        unsigned* bar = b.bar;
        __builtin_amdgcn_s_waitcnt(0);
        unsigned nloc = b.st[0], nx = b.st[1];
        if (nloc == 0u) { xcd_barrier_complete(bar, b.x, nloc, nx); b.st[0] = nloc; b.st[1] = nx; }
        const unsigned old = xb_add(&bar[XB_XSUB(b.x)], 1u);
        const unsigned gen = old / nloc;
        if (old + 1u == (gen + 1u) * nloc) {
            __builtin_amdgcn_fence(__ATOMIC_RELEASE, "agent");
            asm volatile("s_waitcnt vmcnt(0)" ::: "memory");
            const unsigned og = xb_add(&bar[XB_TOP], 1u);
            const unsigned tg = og / nx;
            if (og + 1u == (tg + 1u) * nx) xb_add(&bar[XB_TOPGEN], 1u);
            else XB_SPIN(xb_ld(&bar[XB_TOPGEN]) == tg, bar);
            __builtin_amdgcn_fence(__ATOMIC_ACQUIRE, "agent");
            xb_add(&bar[XB_XGEN(b.x)], 1u);
            asm volatile("s_waitcnt vmcnt(0)" ::: "memory");
        } else {
            XB_SPIN(xb_ld(&bar[XB_XGEN(b.x)]) == gen, bar);
            __builtin_amdgcn_fence(__ATOMIC_ACQUIRE, "agent");
            asm volatile("s_waitcnt vmcnt(0)" ::: "memory");
        }
    }
    __syncthreads();
}

namespace pg8 {
constexpr int BM = 256, BK = 64, HALF = 128, HTB = HALF * BK * 2, STAGE_BYTES = 8 * HTB, NXCD = 8, WGM = 8;
__host__ __device__ __forceinline__ int lds_byte(int r, int c) { const int st = (r >> 4) * 2 + (c >> 5), rr = r & 15, cc = c & 31, ob = rr * 64 + cc * 2; return st * 1024 + (ob ^ (((ob >> 9) & 1) << 5)); }
__host__ __device__ __forceinline__ void stage_rc(int b, int& R, int& C) { const int st = b / 1024, sb = b % 1024, swz = sb ^ (((sb >> 9) & 1) << 5); R = (st >> 1) * 16 + swz / 64; C = (st & 1) * 32 + (swz % 64) / 2; }
__host__ __device__ __forceinline__ int perm32(int rho) { const int n = rho >> 4, i = rho & 15; return 8 * (i >> 2) + 4 * n + (i & 3); }
struct Unit { int pm, pn; };
struct Gemm { const bf16_t* A; const bf16_t* Bt; };
template <int M_, int N_> struct StaticOrder {
    static constexpr int nM = M_ / BM, nN = N_ / BM, nwg = nM * nN;
    int G, c;
    __host__ __device__ void init(int G_, int c_) { G = G_; c = c_; }
    __host__ __device__ bool next(int i, Unit& u) const {
        const long L = (long)i * G + c; if (L >= nwg) return false;
        int wgid = (int)L; { const int q = nwg / NXCD, r = nwg % NXCD, xcd = wgid % NXCD, off = wgid / NXCD; wgid = (xcd < r ? xcd * (q + 1) : r * (q + 1) + (xcd - r) * q) + off; }
        const int nig = WGM * nN, gid = wgid / nig, fm = gid * WGM, gsz = (nM - fm) < WGM ? (nM - fm) : WGM;
        u.pm = fm + ((wgid % nig) % gsz); u.pn = (wgid % nig) / gsz; return true;
    }
};

template <class Epi, int M_, int N_, int K_>
__device__ __forceinline__ void gemm_phase(LAS unsigned char* lds, const Gemm g, const StaticOrder<M_, N_>& S, const Epi& E, int stagger_ticks) {
    int tid = threadIdx.x; asm volatile("" : "+v"(tid));
    const int wid = __builtin_amdgcn_readfirstlane(tid >> 6), lane = tid & 63, wr = wid >> 2, wc = wid & 3, fr = lane & 15, fq = lane >> 4;
    constexpr int K = K_, nt = K / BK;
    unsigned voffA[2], voffB[2];
#pragma unroll
    for (int i = 0; i < 2; ++i) { int R, C; stage_rc(tid * 16 + i * 8192, R, C); const int Rb = Epi::brow(R);
        voffA[i] = (unsigned)(R * K + C) * 2u; voffB[i] = (unsigned)(Rb * K + C) * 2u; }
    constexpr size_t kstep = (size_t)(BK * 2);
    constexpr size_t hstep = (size_t)HALF * K * 2;
    constexpr size_t hstepB = (size_t)Epi::BHROWS * K * 2;
    constexpr size_t tstep = 2 * hstep;
    const unsigned ldsw = (unsigned)wid * 1024u;
    const int aoff = lds_byte(wr * 64 + fr, fq * 8), boff = lds_byte(wc * 32 + fr, fq * 8);
#define PG8_SA(b, h) (((b) * 2 + (h)) * HTB)
#define PG8_SB(b, h) ((4 + (b) * 2 + (h)) * HTB)
#define PG8_STAGE(bufoff, gbase, voff) do { _Pragma("unroll") for (int _i = 0; _i < 2; ++_i) \
        __builtin_amdgcn_global_load_lds((const unsigned*)((const char*)(gbase) + (voff)[_i]), (LAS unsigned*)(lds + (bufoff) + ldsw + _i * 8192), 16, 0, 0); } while (0)
#define PG8_LDA(dst, b, h) do { _Pragma("unroll") for (int m = 0; m < 4; ++m) _Pragma("unroll") for (int k = 0; k < 2; ++k) dst[m][k] = *(const LAS bf16x8*)(lds + PG8_SA(b, h) + aoff + m * 2048 + k * 1024); } while (0)
#define PG8_LDB(dst, b, h) do { _Pragma("unroll") for (int n = 0; n < 2; ++n) _Pragma("unroll") for (int k = 0; k < 2; ++k) dst[n][k] = *(const LAS bf16x8*)(lds + PG8_SB(b, h) + boff + n * 2048 + k * 1024); } while (0)
#define PG8_MMA(ai, bj, At, Bt) do { __builtin_amdgcn_s_setprio(1); _Pragma("unroll") for (int m = 0; m < 4; ++m) _Pragma("unroll") for (int n = 0; n < 2; ++n) _Pragma("unroll") for (int k = 0; k < 2; ++k) \
        acc[ai][bj][m][n] = __builtin_amdgcn_mfma_f32_16x16x32_bf16(Bt[n][k], At[m][k], acc[ai][bj][m][n], 0, 0, 0); __builtin_amdgcn_s_setprio(0); } while (0)
#define PG8_WAIT_V(n) asm volatile("s_waitcnt vmcnt(" #n ")" ::: "memory")
#define PG8_WAIT_L(n) asm volatile("s_waitcnt lgkmcnt(" #n ")" ::: "memory")
#define PG8_BAR __builtin_amdgcn_s_barrier()
#define PG8_SCHED __builtin_amdgcn_sched_barrier(0)
    Unit cur, nxt; int ui = 0;
    if (!S.next(0, cur)) return;
    if (stagger_ticks) {
        const unsigned long long t0 = __builtin_amdgcn_s_memrealtime(); const unsigned long long w = (unsigned long long)((S.c >> 3) & 15) * (unsigned)stagger_ticks;
        while (__builtin_amdgcn_s_memrealtime() - t0 < w) __builtin_amdgcn_s_sleep(8);
    }
    f32x4 acc[2][2][4][2];
#pragma unroll
    for (int a = 0; a < 2; ++a)
#pragma unroll
        for (int b = 0; b < 2; ++b)
#pragma unroll
            for (int m = 0; m < 4; ++m)
#pragma unroll
                for (int n = 0; n < 2; ++n) acc[a][b][m][n] = (f32x4){0.f, 0.f, 0.f, 0.f};
    bf16x8 At[4][2], B0[2][2], B1[2][2];
    const char* cA = (const char*)g.A + (size_t)cur.pm * tstep; const char* cB = (const char*)g.Bt + (size_t)cur.pn * tstep;
    PG8_STAGE(PG8_SB(0, 0), cB, voffB); PG8_STAGE(PG8_SA(0, 0), cA, voffA); PG8_STAGE(PG8_SB(0, 1), cB + hstepB, voffB); PG8_STAGE(PG8_SA(0, 1), cA + hstep, voffA);
    if (wr == 1) PG8_BAR;
    PG8_WAIT_V(4); PG8_BAR;
    PG8_STAGE(PG8_SB(1, 0), cB + kstep, voffB); PG8_STAGE(PG8_SA(1, 0), cA + kstep, voffA); PG8_STAGE(PG8_SB(1, 1), cB + hstepB + kstep, voffB);
    PG8_WAIT_V(6); PG8_BAR;
    for (;;) {
        const bool has_next = S.next(ui + 1, nxt);
        const char* nA = has_next ? (const char*)g.A + (size_t)nxt.pm * tstep : cA; const char* nB = has_next ? (const char*)g.Bt + (size_t)nxt.pn * tstep : cB;
        for (int t = 0; t < nt; t += 2) {
            const bool last = (t == nt - 2);
            const char* a1 = cA + (size_t)(t + 1) * kstep;
            const char* a2 = last ? nA : cA + (size_t)(t + 2) * kstep; const char* b2 = last ? nB : cB + (size_t)(t + 2) * kstep;
            const char* a3 = a2 + kstep; const char* b3 = b2 + kstep;
            PG8_LDB(B0, 0, 0); PG8_SCHED; PG8_LDA(At, 0, 0); PG8_STAGE(PG8_SA(1, 1), a1 + hstep, voffA);
            PG8_WAIT_L(8); PG8_BAR; PG8_WAIT_L(0); PG8_MMA(0, 0, At, B0); PG8_BAR; PG8_SCHED;
            PG8_LDB(B1, 0, 1); PG8_STAGE(PG8_SB(0, 0), b2, voffB);
            PG8_BAR; PG8_WAIT_L(0); PG8_MMA(0, 1, At, B1); PG8_BAR;
            PG8_LDA(At, 0, 1); PG8_STAGE(PG8_SA(0, 0), a2, voffA);
            PG8_BAR; PG8_WAIT_L(0); PG8_MMA(1, 0, At, B0); PG8_BAR; PG8_SCHED;
            PG8_STAGE(PG8_SB(0, 1), b2 + hstepB, voffB);
            PG8_WAIT_V(6); PG8_BAR; PG8_MMA(1, 1, At, B1); PG8_BAR;
            PG8_LDB(B0, 1, 0); PG8_SCHED; PG8_LDA(At, 1, 0); PG8_STAGE(PG8_SA(0, 1), a2 + hstep, voffA);
            PG8_WAIT_L(8); PG8_BAR; PG8_WAIT_L(0); PG8_MMA(0, 0, At, B0); PG8_BAR; PG8_SCHED;
            PG8_LDB(B1, 1, 1); PG8_STAGE(PG8_SB(1, 0), b3, voffB);
            PG8_BAR; PG8_WAIT_L(0); PG8_MMA(0, 1, At, B1); PG8_BAR;
            PG8_LDA(At, 1, 1); PG8_STAGE(PG8_SA(1, 0), a3, voffA);
            PG8_BAR; PG8_WAIT_L(0); PG8_MMA(1, 0, At, B0); PG8_BAR; PG8_SCHED;
            PG8_STAGE(PG8_SB(1, 1), b3 + hstepB, voffB);
            PG8_WAIT_V(6); PG8_BAR; PG8_MMA(1, 1, At, B1); PG8_BAR;
        }
        E(acc, cur, wr, wc, fr, fq);
        if (!has_next) break;
#pragma unroll
        for (int a = 0; a < 2; ++a)
#pragma unroll
            for (int b = 0; b < 2; ++b)
#pragma unroll
                for (int m = 0; m < 4; ++m)
#pragma unroll
                    for (int n = 0; n < 2; ++n) acc[a][b][m][n] = (f32x4){0.f, 0.f, 0.f, 0.f};
        cur = nxt; cA = nA; cB = nB; ++ui;
    }
    PG8_WAIT_V(0);
    if (wr == 0) PG8_BAR;
    PG8_BAR;
#undef PG8_SA
#undef PG8_SB
#undef PG8_STAGE
#undef PG8_LDA
#undef PG8_LDB
#undef PG8_MMA
#undef PG8_WAIT_V
#undef PG8_WAIT_L
#undef PG8_BAR
#undef PG8_SCHED
}
}

struct EpiIn {
    static constexpr int BHROWS = 64;
    __host__ __device__ static __forceinline__ int brow(int R) { const int wc = R >> 5; return 128 * (wc >> 1) + 32 * (wc & 1) + pg8::perm32(R & 31); }
    bf16_t* qkvg; float* out; const float* cosT; const float* ssq; int l;
    __device__ __forceinline__ void operator()(const f32x4 (&acc)[2][2][4][2], const pg8::Unit& u, int wr, int wc, int fr, int fq) const {
        float* ob = out; asm volatile("" : "+s"(ob)); ob = as_global(ob);
        const int rope = (l & 1) ^ 1;
        float* outk_p = ob + OK_P + (size_t)l * MP * D; float* outv_p = ob + OV_P + (size_t)l * MP * D;
        float* outk_s = ob + OK_S + (size_t)l * MS * D; float* outv_s = ob + OV_S + (size_t)l * MS * D;
        const float* sinT = cosT + (size_t)SEQ * 64;
        const int sec = u.pn >> 2, ct = (u.pn & 3) * 256 + 128 * (wc >> 1) + 32 * (wc & 1) + 8 * fq;
        const int row0 = u.pm * 256 + wr * 64 + fr;
        const bool prompt = u.pm < (MP / 256);
        const bool dof = (sec == 1) || (sec == 2);
        float* fo = (sec == 1) ? (prompt ? outk_p : outk_s - (size_t)MP * D) : (prompt ? outv_p : outv_s - (size_t)MP * D);
        const bool dorope = rope && sec < 2;
        const float qs = (!rope && sec == 0) ? 0.0625f : 1.0f;
        const int dcol = 32 * (wc & 1) + 8 * fq;
        float rsv[8];
#pragma unroll
        for (int i = 0; i < 8; ++i) rsv[i] = __hip_atomic_load(ssq + row0 + (i >> 2) * 128 + (i & 3) * 16, __ATOMIC_RELAXED, __HIP_MEMORY_SCOPE_AGENT);
        f32x4 cA[2], sA[2], cB[2], sB[2];
#define RPOS(i_) (prompt ? ((row0 + ((i_) >> 2) * 128 + ((i_) & 3) * 16) & (SEQ - 1)) : PAST + ((row0 + ((i_) >> 2) * 128 + ((i_) & 3) * 16 - MP) & (DSEQ - 1)))
        if (dorope) {
#pragma unroll
            for (int n = 0; n < 2; ++n) { cA[n] = *(const f32x4*)(cosT + (size_t)RPOS(0) * 64 + dcol + 4 * n); sA[n] = *(const f32x4*)(sinT + (size_t)RPOS(0) * 64 + dcol + 4 * n);
                                          cB[n] = *(const f32x4*)(cosT + (size_t)RPOS(1) * 64 + dcol + 4 * n); sB[n] = *(const f32x4*)(sinT + (size_t)RPOS(1) * 64 + dcol + 4 * n); } }
#pragma unroll
        for (int ai = 0; ai < 2; ++ai)
#pragma unroll
            for (int m = 0; m < 4; ++m) {
                const int row = row0 + ai * 128 + m * 16;
                const float rs = qs / sqrtf(rsv[ai * 4 + m] * (1.0f / D) + EPS);
                f32x4 v[2][2];
#pragma unroll
                for (int bj = 0; bj < 2; ++bj)
#pragma unroll
                    for (int n = 0; n < 2; ++n) v[bj][n] = acc[ai][bj][m][n] * rs;
                if (dorope) {
                    f32x4 cC[2] = {cA[0], cA[1]}, sC[2] = {sA[0], sA[1]};
#pragma unroll
                    for (int n = 0; n < 2; ++n) { cA[n] = cB[n]; sA[n] = sB[n]; }
                    if (ai * 4 + m < 6) {
#pragma unroll
                        for (int n = 0; n < 2; ++n) { cB[n] = *(const f32x4*)(cosT + (size_t)RPOS(ai * 4 + m + 2) * 64 + dcol + 4 * n); sB[n] = *(const f32x4*)(sinT + (size_t)RPOS(ai * 4 + m + 2) * 64 + dcol + 4 * n); } }
#pragma unroll
                    for (int n = 0; n < 2; ++n) {
                        const f32x4 x1 = v[0][n], x2 = v[1][n];
                        v[0][n] = x1 * cC[n] - x2 * sC[n]; v[1][n] = x2 * cC[n] + x1 * sC[n];
                    }
                }
                bf16_t* qp = qkvg + (size_t)row * NIN + sec * 1024 + ct;
#pragma unroll
                for (int bj = 0; bj < 2; ++bj) {
                    u32x4 w; w.x = cvtpk(v[bj][0][0], v[bj][0][1]); w.y = cvtpk(v[bj][0][2], v[bj][0][3]); w.z = cvtpk(v[bj][1][0], v[bj][1][1]); w.w = cvtpk(v[bj][1][2], v[bj][1][3]);
                    *(u32x4*)(qp + bj * 64) = w;
                }
                if (dof) {
                    GAS float* fp = (GAS float*)(fo + (size_t)row * D + ct);
#pragma unroll
                    for (int bj = 0; bj < 2; ++bj) { __builtin_nontemporal_store(v[bj][0], (GAS f32x4*)(fp + bj * 64)); __builtin_nontemporal_store(v[bj][1], (GAS f32x4*)(fp + bj * 64 + 4)); }
                }
            }
    }
};
struct EpiOut {
    static constexpr int BHROWS = 128;
    __host__ __device__ static __forceinline__ int brow(int R) { return (R & ~31) + pg8::perm32(R & 31); }
    const float* x0p; const float* x0s; bf16_t* xb; float* ssq;
    __device__ __forceinline__ void operator()(const f32x4 (&acc)[2][2][4][2], const pg8::Unit& u, int wr, int wc, int fr, int fq) const {
        const int row0 = u.pm * 256 + wr * 64 + fr, col0 = u.pn * 256 + wc * 32 + 8 * fq;
#define YROW(i_) ((size_t)(row0 + ((i_) >> 2) * 128 + ((i_) & 3) * 16) * D + col0)
        if (x0p) {
            const float* yi = (u.pm < (MP / 256)) ? x0p : x0s;
            f32x4 yA[2][2], yB[2][2];
#pragma unroll
            for (int bj = 0; bj < 2; ++bj)
#pragma unroll
                for (int n = 0; n < 2; ++n) { yA[bj][n] = *(const f32x4*)(yi + YROW(0) + bj * 128 + n * 4); yB[bj][n] = *(const f32x4*)(yi + YROW(1) + bj * 128 + n * 4); }
#pragma unroll
            for (int g8 = 0; g8 < 8; ++g8) { const int ai = g8 >> 2, m = g8 & 3; const int row = row0 + ai * 128 + m * 16; const size_t ro = (size_t)row * D + col0;
                f32x4 yC[2][2];
#pragma unroll
                for (int bj = 0; bj < 2; ++bj)
#pragma unroll
                    for (int n = 0; n < 2; ++n) { yC[bj][n] = yA[bj][n]; yA[bj][n] = yB[bj][n]; }
                if (g8 < 6) {
#pragma unroll
                    for (int bj = 0; bj < 2; ++bj)
#pragma unroll
                        for (int n = 0; n < 2; ++n) yB[bj][n] = *(const f32x4*)(yi + YROW(g8 + 2) + bj * 128 + n * 4); }
                float s = 0.f;
#pragma unroll
                for (int bj = 0; bj < 2; ++bj) { const f32x4 y0 = yC[bj][0] + acc[ai][bj][m][0], y1 = yC[bj][1] + acc[ai][bj][m][1];
                    const u32x4 w = {cvtpk(y0[0], y0[1]), cvtpk(y0[2], y0[3]), cvtpk(y1[0], y1[1]), cvtpk(y1[2], y1[3])};
                    *(u32x4*)(xb + ro + bj * 128) = w;
#pragma unroll
                    for (int e = 0; e < 4; ++e) { const float a0 = bf_lo(w[e]), a1 = bf_hi(w[e]); s += a0 * a0 + a1 * a1; } }
                s += xor_lane<16>(s); { auto rr = __builtin_amdgcn_permlane32_swap(__float_as_uint(s), __float_as_uint(s), false, false); s = __uint_as_float(rr[0]) + __uint_as_float(rr[1]); }
                if (fq == 0) __hip_atomic_fetch_add(ssq + row, s, __ATOMIC_RELAXED, __HIP_MEMORY_SCOPE_AGENT); }
        } else {
            u32x4 yA[2], yB[2];
#pragma unroll
            for (int bj = 0; bj < 2; ++bj) { yA[bj] = *(const u32x4*)(xb + YROW(0) + bj * 128); yB[bj] = *(const u32x4*)(xb + YROW(1) + bj * 128); }
#pragma unroll
            for (int g8 = 0; g8 < 8; ++g8) { const int ai = g8 >> 2, m = g8 & 3; const int row = row0 + ai * 128 + m * 16; const size_t ro = (size_t)row * D + col0;
                u32x4 yC[2];
#pragma unroll
                for (int bj = 0; bj < 2; ++bj) { yC[bj] = yA[bj]; yA[bj] = yB[bj]; }
                if (g8 < 6) {
#pragma unroll
                    for (int bj = 0; bj < 2; ++bj) yB[bj] = *(const u32x4*)(xb + YROW(g8 + 2) + bj * 128); }
                float s = 0.f;
#pragma unroll
                for (int bj = 0; bj < 2; ++bj) { const f32x4 a0v = acc[ai][bj][m][0], a1v = acc[ai][bj][m][1]; const u32x4 yo = yC[bj];
                    const u32x4 w = {cvtpk(bf_lo(yo[0]) + a0v[0], bf_hi(yo[0]) + a0v[1]), cvtpk(bf_lo(yo[1]) + a0v[2], bf_hi(yo[1]) + a0v[3]),
                                     cvtpk(bf_lo(yo[2]) + a1v[0], bf_hi(yo[2]) + a1v[1]), cvtpk(bf_lo(yo[3]) + a1v[2], bf_hi(yo[3]) + a1v[3])};
                    *(u32x4*)(xb + ro + bj * 128) = w;
#pragma unroll
                    for (int e = 0; e < 4; ++e) { const float a0 = bf_lo(w[e]), a1 = bf_hi(w[e]); s += a0 * a0 + a1 * a1; } }
                if (ssq) { s += xor_lane<16>(s); { auto rr = __builtin_amdgcn_permlane32_swap(__float_as_uint(s), __float_as_uint(s), false, false); s = __uint_as_float(rr[0]) + __uint_as_float(rr[1]); }
                    if (fq == 0) __hip_atomic_fetch_add(ssq + row, s, __ATOMIC_RELAXED, __HIP_MEMORY_SCOPE_AGENT); } }
        }
#undef YROW
    }
};

constexpr int NW = 8, NTHR = 512;
constexpr int LDS_MAIN = 131072, LDS_SCR = LDS_MAIN, LDS_SCR_BYTES = 8 * 512, LDS_MISC = LDS_SCR + LDS_SCR_BYTES, LDS_BYTES = LDS_MISC + 256;

__device__ __forceinline__ int ltid() { int t = threadIdx.x; asm volatile("" : "+v"(t)); return t; }
__device__ __forceinline__ void norm_phase(const float* xp, const float* xs  , const float* g, bf16_t* hb, float* op, float* os  , float* ssq, int mode) {
    const int tid = ltid(), lane = tid & 63, wid = tid >> 6;
    f32x4 gw[4];
#pragma unroll
    for (int i = 0; i < 2; ++i) { gw[2 * i] = *(const f32x4*)(g + i * 512 + lane * 8); gw[2 * i + 1] = *(const f32x4*)(g + i * 512 + lane * 8 + 4); }
    const int rstep = gridDim.x * NW;
    f32x4 vn[4];
    { const int row = blockIdx.x * NW + wid; if (row < MTOT) { const float* x = (row < MP ? xp : xs) + (size_t)row * D;
#pragma unroll
        for (int i = 0; i < 2; ++i) { vn[2 * i] = *(const f32x4*)(x + i * 512 + lane * 8); vn[2 * i + 1] = *(const f32x4*)(x + i * 512 + lane * 8 + 4); } } }
    for (int row = blockIdx.x * NW + wid; row < MTOT; row += rstep) {
        f32x4 v[4];
#pragma unroll
        for (int i = 0; i < 4; ++i) v[i] = vn[i];
        if (row + rstep < MTOT) { const float* x = (row + rstep < MP ? xp : xs) + (size_t)(row + rstep) * D;
#pragma unroll
            for (int i = 0; i < 2; ++i) { vn[2 * i] = *(const f32x4*)(x + i * 512 + lane * 8); vn[2 * i + 1] = *(const f32x4*)(x + i * 512 + lane * 8 + 4); } }
        float s = 0.f;
#pragma unroll
        for (int i = 0; i < 4; ++i) s += v[i][0] * v[i][0] + v[i][1] * v[i][1] + v[i][2] * v[i][2] + v[i][3] * v[i][3];
        s = wave_sum(s);
        if (mode == 2) { if (lane == 0) ssq[row] = s; }
        else { const float r = 1.0f / sqrtf(s * (1.0f / D) + EPS);
#pragma unroll
            for (int i = 0; i < 4; ++i) v[i] = v[i] * r * gw[i]; }
        if (mode != 1) {
#pragma unroll
            for (int i = 0; i < 2; ++i) { u32x4 w; w.x = cvtpk(v[2 * i][0], v[2 * i][1]); w.y = cvtpk(v[2 * i][2], v[2 * i][3]); w.z = cvtpk(v[2 * i + 1][0], v[2 * i + 1][1]); w.w = cvtpk(v[2 * i + 1][2], v[2 * i + 1][3]);
                *(u32x4*)(hb + (size_t)row * D + i * 512 + lane * 8) = w; }
        } else {
            float* o = (row < MP ? op : os) + (size_t)row * D;
#pragma unroll
            for (int i = 0; i < 2; ++i) { __builtin_nontemporal_store(v[2 * i], (f32x4*)(o + i * 512 + lane * 8)); __builtin_nontemporal_store(v[2 * i + 1], (f32x4*)(o + i * 512 + lane * 8 + 4)); }
        }
    }
}
__device__ __forceinline__ void final_norm(const bf16_t* xb, const float* g, float* op, float* os  ) {
    const int tid = ltid(), lane = tid & 63, wid = tid >> 6;
    f32x4 gw[4];
#pragma unroll
    for (int i = 0; i < 2; ++i) { gw[2 * i] = *(const f32x4*)(g + i * 512 + lane * 8); gw[2 * i + 1] = *(const f32x4*)(g + i * 512 + lane * 8 + 4); }
    const int rstep = gridDim.x * NW;
    u32x4 vn[2];
    { const int row = blockIdx.x * NW + wid; if (row < MTOT) {
#pragma unroll
        for (int i = 0; i < 2; ++i) vn[i] = *(const u32x4*)(xb + (size_t)row * D + i * 512 + lane * 8); } }
    for (int row = blockIdx.x * NW + wid; row < MTOT; row += rstep) {
        f32x4 v[4];
#pragma unroll
        for (int i = 0; i < 2; ++i) { v[2 * i] = (f32x4){bf_lo(vn[i][0]), bf_hi(vn[i][0]), bf_lo(vn[i][1]), bf_hi(vn[i][1])}; v[2 * i + 1] = (f32x4){bf_lo(vn[i][2]), bf_hi(vn[i][2]), bf_lo(vn[i][3]), bf_hi(vn[i][3])}; }
        if (row + rstep < MTOT) {
#pragma unroll
            for (int i = 0; i < 2; ++i) vn[i] = *(const u32x4*)(xb + (size_t)(row + rstep) * D + i * 512 + lane * 8); }
        float s = 0.f;
#pragma unroll
        for (int i = 0; i < 4; ++i) s += v[i][0] * v[i][0] + v[i][1] * v[i][1] + v[i][2] * v[i][2] + v[i][3] * v[i][3];
        s = wave_sum(s);
        const float r = 1.0f / sqrtf(s * (1.0f / D) + EPS);
        float* o = (row < MP ? op : os) + (size_t)row * D;
#pragma unroll
        for (int i = 0; i < 2; ++i) { __builtin_nontemporal_store(v[2 * i] * r * gw[2 * i], (f32x4*)(o + i * 512 + lane * 8)); __builtin_nontemporal_store(v[2 * i + 1] * r * gw[2 * i + 1], (f32x4*)(o + i * 512 + lane * 8 + 4)); }
    }
}
__device__ __forceinline__ void transpose_weights(const float* W, const float* kscale  , bf16_t* Wt, int N, int nmat, LAS float* sm) {
    const int tid = ltid();
    const int tilesN = N / 64, tilesK = D / 128, per = tilesN * tilesK, total = per * nmat;
    for (int t = blockIdx.x; t < total; t += gridDim.x) {
        const int mat = t / per, tt = t % per, tk = tt / tilesN, tn = tt % tilesN;
        const float* src = W + (size_t)mat * D * N + (size_t)(tk * 128) * N + tn * 64;
        __syncthreads();
#pragma unroll
        for (int p = 0; p < 4; ++p) { const int r = p * 32 + (tid >> 4), c = (tid & 15) * 4; *(LAS f32x4*)(sm + r * 68 + c) = *(const f32x4*)(src + (size_t)r * N + c); }
        __syncthreads();
        const int n = tid & 63, kc = tid >> 6;
        unsigned w[8];
#pragma unroll
        for (int i = 0; i < 8; ++i) { const int k0 = kc * 16 + 2 * i; const float s0 = kscale ? kscale[mat * D + tk * 128 + k0] : 1.f, s1 = kscale ? kscale[mat * D + tk * 128 + k0 + 1] : 1.f;
            w[i] = cvtpk(sm[k0 * 68 + n] * s0, sm[(k0 + 1) * 68 + n] * s1); }
        bf16_t* dst = Wt + (size_t)mat * N * D + (size_t)(tn * 64 + n) * D + tk * 128 + kc * 16;
        *(u32x4*)dst = (u32x4){w[0], w[1], w[2], w[3]}; *(u32x4*)(dst + 8) = (u32x4){w[4], w[5], w[6], w[7]};
    }
    __syncthreads();
}
__device__ __forceinline__ void convert_bf16(const float* src, bf16_t* dst, size_t n) {
    const size_t stride = (size_t)gridDim.x * NTHR * 8 * 4;
    const int tid = ltid();
    for (size_t i = ((size_t)blockIdx.x * 4 * NTHR + tid) * 8; i < n; i += stride) {
        f32x4 a[4], b[4];
#pragma unroll
        for (int u = 0; u < 4; ++u) { a[u] = __builtin_nontemporal_load((const f32x4*)(src + i + (size_t)u * NTHR * 8)); b[u] = __builtin_nontemporal_load((const f32x4*)(src + i + (size_t)u * NTHR * 8 + 4)); }
#pragma unroll
        for (int u = 0; u < 4; ++u) { u32x4 w; w.x = cvtpk(a[u][0], a[u][1]); w.y = cvtpk(a[u][2], a[u][3]); w.z = cvtpk(b[u][0], b[u][1]); w.w = cvtpk(b[u][2], b[u][3]);
            __builtin_nontemporal_store(w, (u32x4*)(dst + i + (size_t)u * NTHR * 8)); }
    }
}
__device__ __forceinline__ void rope_table(float* cosT, float* sinT) {
    const int tid = ltid();
    for (int i = blockIdx.x * NTHR + tid; i < SEQ * 64; i += gridDim.x * NTHR) {
        const int pos = i >> 6, d = i & 63;
        const float inv = (float)pow(10000.0, -(double)d / 64.0);
        const float ang = (float)pos * inv;
        cosT[i] = (float)cos((double)ang); sinT[i] = (float)sin((double)ang);
    }
}


namespace att {
constexpr int KBUF = 32768, VBUF = 32768, LV0 = 65536;
__device__ __forceinline__ int swap23(int k) { return (k & ~0xC) | ((k & 4) << 1) | ((k & 8) >> 1); }
__device__ __forceinline__ int v_rd_base(int lane) { return ((lane & 3) << 3) | (((lane >> 2) & 3) << 6) | (((lane >> 4) & 1) << 5) | (((lane >> 5) & 1) << 8); }
constexpr int v_rd_off(int d0, int ks, int half) { return d0 * 512 + ks * 8192 + half * 4096; }
__device__ __forceinline__ int crow(int r, int hi) { return (r & 3) + 8 * (r >> 2) + 4 * hi; }
#define SBAR() __builtin_amdgcn_sched_barrier(0)
#define WGBAR() do { asm volatile("" ::: "memory"); __builtin_amdgcn_s_barrier(); asm volatile("" ::: "memory"); } while (0)
#define GLDS(gp, lp) __builtin_amdgcn_global_load_lds((const unsigned*)(gp), (LAS unsigned*)(lp), 16, 0, 0)
#define PK4(P, B_, OUT) do { unsigned a0 = cvtpk(P[B_+0], P[B_+1]), a1 = cvtpk(P[B_+2], P[B_+3]);                          \
        unsigned b0 = cvtpk(P[B_+4], P[B_+5]), b1 = cvtpk(P[B_+6], P[B_+7]);                                             \
        auto r0 = __builtin_amdgcn_permlane32_swap(a0, b0, false, false); auto r1 = __builtin_amdgcn_permlane32_swap(a1, b1, false, false); \
        u32x4 w = {r0[0], r1[0], r0[1], r1[1]}; OUT = *reinterpret_cast<bf16x8*>(&w); } while (0)
#define TRRD(dst, addr, off) asm volatile("ds_read_b64_tr_b16 %0, %1 offset:%2" : "=&v"(dst) : "v"(addr), "i"(off) : "memory")
#define PV_DECL() s16x4 Al0, Al1, Al2, Al3, Ah0, Ah1, Ah2, Ah3, Bl0, Bl1, Bl2, Bl3, Bh0, Bh1, Bh2, Bh3
#define PV_LOAD(S_, vb, d0) do { constexpr int b_ = v_rd_off(d0, 0, 0);   \
        TRRD(S_##l0, vb, b_); TRRD(S_##h0, vb, b_ + 4096); TRRD(S_##l1, vb, b_ + 8192); TRRD(S_##h1, vb, b_ + 12288); \
        TRRD(S_##l2, vb, b_ + 16384); TRRD(S_##h2, vb, b_ + 20480); TRRD(S_##l3, vb, b_ + 24576); TRRD(S_##h3, vb, b_ + 28672); } while (0)
#define PV_MMA(o_, S_) do {             \
        o_ = __builtin_amdgcn_mfma_f32_32x32x16_bf16(pa0, (bf16x8){S_##l0[0], S_##l0[1], S_##l0[2], S_##l0[3], S_##h0[0], S_##h0[1], S_##h0[2], S_##h0[3]}, o_, 0, 0, 0);   \
        o_ = __builtin_amdgcn_mfma_f32_32x32x16_bf16(pa1, (bf16x8){S_##l1[0], S_##l1[1], S_##l1[2], S_##l1[3], S_##h1[0], S_##h1[1], S_##h1[2], S_##h1[3]}, o_, 0, 0, 0);   \
        o_ = __builtin_amdgcn_mfma_f32_32x32x16_bf16(pa2, (bf16x8){S_##l2[0], S_##l2[1], S_##l2[2], S_##l2[3], S_##h2[0], S_##h2[1], S_##h2[2], S_##h2[3]}, o_, 0, 0, 0);   \
        o_ = __builtin_amdgcn_mfma_f32_32x32x16_bf16(pa3, (bf16x8){S_##l3[0], S_##l3[1], S_##l3[2], S_##l3[3], S_##h3[0], S_##h3[1], S_##h3[2], S_##h3[3]}, o_, 0, 0, 0); } while (0)
#define LGKM(n) do { asm volatile("s_waitcnt lgkmcnt(" #n ")" ::: "memory"); SBAR(); } while (0)
struct KVSrc { const char* k0; const char* k1; unsigned vd0, vd1; int stride0, stride1, nsplit; };
__device__ __forceinline__ void kv_tile(const KVSrc& s, int j, const char*& kt, const char*& vt, int& strideB) {
    const bool first = j < s.nsplit;
    strideB = first ? s.stride0 : s.stride1;
    const size_t off = (size_t)(first ? j : j - s.nsplit) * 64 * strideB;
    kt = (first ? s.k0 : s.k1) + off; vt = kt + (first ? s.vd0 : s.vd1);
}
__device__ __forceinline__ void issue_V(LAS unsigned char* lds, int buf, const char* vt, int strideB, int wid, int lane) {
    const int kV = swap23(8 * wid + ((lane & 31) >> 2));
    const char* src = vt + (size_t)kV * strideB + (lane >> 5) * 64 + (lane & 3) * 16;
    LAS unsigned char* dst = lds + LV0 + buf * VBUF + wid * 4096;
#pragma unroll
    for (int jj = 0; jj < 4; ++jj) GLDS(src + jj * 128, dst + jj * 1024);
}

struct DItem { const bf16_t* q; KVSrc kv; int nt_lo, nt_hi; bf16_t* o; const float* kf; const float* vf; int desc; };
__device__ __forceinline__ void issue_K2(LAS unsigned char* lds, int buf, const char* kt, int strideB, int wid, int lane) {
    const int map = wid >> 2, jrow = wid & 3, rowL = 4 * jrow + (lane >> 4);
    const char* src = kt + (size_t)rowL * strideB + map * 256 + (((lane & 15) ^ rowL) << 4);
    LAS unsigned char* dst = lds + buf * KBUF + map * 16384 + jrow * 1024;
#pragma unroll
    for (int jj = 0; jj < 4; ++jj) GLDS(src + (size_t)jj * 16 * strideB, dst + jj * 4096);
}
struct Dma { const char* src; LAS unsigned char* dst; int sstep, dstep; };
__device__ __forceinline__ Dma dma_K2(LAS unsigned char* lds, int buf, const char* kt, int strideB, int wid, int lane) {
    const int map = wid >> 2, jrow = wid & 3, rowL = 4 * jrow + (lane >> 4);
    Dma d; d.src = kt + (size_t)rowL * strideB + map * 256 + (((lane & 15) ^ rowL) << 4); d.dst = lds + buf * KBUF + map * 16384 + jrow * 1024; d.sstep = 16 * strideB; d.dstep = 4096; return d; }
__device__ __forceinline__ Dma dma_V(LAS unsigned char* lds, int buf, const char* vt, int strideB, int wid, int lane) {
    const int kV = swap23(8 * wid + ((lane & 31) >> 2));
    Dma d; d.src = vt + (size_t)kV * strideB + (lane >> 5) * 64 + (lane & 3) * 16; d.dst = lds + LV0 + buf * VBUF + wid * 4096; d.sstep = 128; d.dstep = 1024; return d; }
#define DMA_PIECE(d_, jj) GLDS((d_).src + (size_t)(jj) * (d_).sstep, (d_).dst + (jj) * (d_).dstep)
constexpr float DSCALE = 0.08838834764831845f, DC2 = 1.4426950408889634f * DSCALE, DTHR = 6.f;

__device__ __forceinline__ void stage_load(f32x4 (&a)[16], const float* base  , int sw, int lane) {
    const float* p = base + (size_t)(16 * sw) * 1024 + lane * 4;
#pragma unroll
    for (int i = 0; i < 16; ++i) a[i] = __builtin_nontemporal_load((const f32x4*)(p + (size_t)i * 1024));
}
__device__ __forceinline__ void stage_write(const f32x4 (&a)[16], LAS unsigned char* lds, int kind, int buf, int sw, int lane) {
    const int c = lane >> 1, hf = (lane & 1) * 8;
#pragma unroll
    for (int i = 0; i < 16; ++i) {
        const int row = 16 * sw + i;
        const u32x2 w = {cvtpk(a[i][0], a[i][1]), cvtpk(a[i][2], a[i][3])};
        if (kind == 0) *(LAS u32x2*)(lds + buf * KBUF + (c >> 4) * 16384 + row * 256 + (((c & 15) ^ (row & 15)) << 4) + hf) = w;
        else { const int kk = swap23(row); *(LAS u32x2*)(lds + LV0 + buf * VBUF + ((kk >> 3) * 8 + (c >> 2)) * 512 + (kk & 7) * 64 + (c & 3) * 16 + hf) = w; }
    }
    asm volatile("s_waitcnt lgkmcnt(0)" ::: "memory");
}
__device__ const float g_post[2] = {0.8f, 0.52928698165641594f};
__device__ __forceinline__ void diff_item(const DItem& it, LAS unsigned char* lds, float lam, int lidx, const float* subw) {
    int tid = threadIdx.x; asm volatile("" : "+v"(tid));
    const int wid = __builtin_amdgcn_readfirstlane(tid >> 6), lane = tid & 63, r32 = lane & 31, hi = lane >> 5;
    const int grp = wid >> 2, wq = wid & 3;
    const int ntw = (wq < 2) ? it.nt_lo : it.nt_hi, NT = it.nt_lo > it.nt_hi ? it.nt_lo : it.nt_hi;
    LAS float* ws = (LAS float*)(lds + LDS_SCR) + wid * 64; LAS float* li_l = ws; LAS float* al_l = ws + 32;
    bf16x8 qr[8];
    if (ntw > 0) { const bf16_t* qp = it.q + (size_t)(wq * 32 + r32) * NIN + grp * 128 + hi * 8;
#pragma unroll
        for (int d0 = 0; d0 < 8; ++d0) qr[d0] = *(const bf16x8*)(qp + d0 * 16); }
    else {
#pragma unroll
        for (int d0 = 0; d0 < 8; ++d0) qr[d0] = (bf16x8){0, 0, 0, 0, 0, 0, 0, 0}; }
    f32x16 o[8];
#pragma unroll
    for (int d0 = 0; d0 < 8; ++d0) o[d0] = f32x16{};
    float m_reg = -1e30f, l_reg = 0.f;
    bf16x8 pa0 = {}, pa1 = {}, pa2 = {}, pa3 = {};
    const int xh = (r32 >> 1) & 7;
    LAS unsigned char* krd = lds + grp * 16384 + r32 * 256 + ((hi ^ (r32 & 1)) << 4);
    const int vb0 = (int)(uintptr_t)(lds + LV0) + v_rd_base(lane);
    const char* kt; const char* vt; int sB;
#define PH(t_) (it.desc ? NT - 1 - (t_) : (t_))
#define ISSUE_K(t_) do { kv_tile(it.kv, PH(t_), kt, vt, sB); issue_K2(lds, (t_) & 1, kt, sB, wid, lane); } while (0)
#define ISSUE_V(t_) do { kv_tile(it.kv, PH(t_), kt, vt, sB); issue_V(lds, (t_) & 1, vt, sB, wid, lane); } while (0)
#define WAIT_BAR(issued) do { if (issued) asm volatile("s_waitcnt vmcnt(4)" ::: "memory"); else asm volatile("s_waitcnt vmcnt(0)" ::: "memory"); WGBAR(); } while (0)
    const bool stg = it.kf != nullptr && wq >= 2;
    const int sw = (wid & 1) + 2 * grp;
#define F32T(j_) (it.kf != nullptr && (j_) < it.kv.nsplit)
    if (stg) {
        f32x4 a[16];
        if (F32T(0)) { stage_load(a, it.kf, sw, lane); asm volatile("s_waitcnt vmcnt(0)" ::: "memory"); stage_write(a, lds, 0, 0, sw, lane);
                       stage_load(a, it.vf, sw, lane); asm volatile("s_waitcnt vmcnt(0)" ::: "memory"); stage_write(a, lds, 1, 0, sw, lane); }
        else { ISSUE_K(0); ISSUE_V(0); asm volatile("s_waitcnt vmcnt(0)" ::: "memory"); }
        int n = 0;
        bool pend = false;
#define PREFETCH() do { const int j_ = 1 + (n >> 1); pend = j_ < NT && F32T(j_); if (pend) stage_load(a, ((n & 1) ? it.vf : it.kf) + (size_t)j_ * 64 * 1024, sw, lane); } while (0)
#define SEG() do { const int kind_ = n & 1, j_ = 1 + (n >> 1); bool did_ = false; \
            if (j_ < NT) { if (pend) { asm volatile("s_waitcnt vmcnt(0)" ::: "memory"); stage_write(a, lds, kind_, j_ & 1, sw, lane); } \
                           else { kv_tile(it.kv, j_, kt, vt, sB); Dma d_ = kind_ ? dma_V(lds, j_ & 1, vt, sB, wid, lane) : dma_K2(lds, j_ & 1, kt, sB, wid, lane); DMA_PIECE(d_, 0); DMA_PIECE(d_, 1); DMA_PIECE(d_, 2); DMA_PIECE(d_, 3); did_ = true; } } \
            ++n; PREFETCH(); \
            if (did_) asm volatile("s_waitcnt vmcnt(4)" ::: "memory"); else if (!pend) asm volatile("s_waitcnt vmcnt(0)" ::: "memory"); \
            WGBAR(); } while (0)
        PREFETCH();
        WGBAR();
        if (grp == 1) SEG();
        for (int t = 0; t < NT; ++t) { SEG(); SEG(); }
        if (grp == 0) WGBAR();
        asm volatile("s_waitcnt vmcnt(0) lgkmcnt(0)" ::: "memory"); WGBAR();
        asm volatile("s_waitcnt vmcnt(0) lgkmcnt(0)" ::: "memory"); WGBAR();
#undef SEG
#undef PREFETCH
        return;
    }
    if (!F32T(0)) { ISSUE_K(0); ISSUE_V(0); }
    asm volatile("s_waitcnt vmcnt(0)" ::: "memory"); WGBAR();
    if (grp == 1) { const bool is = 1 < NT && !F32T(1); if (is) ISSUE_K(1); WAIT_BAR(is); }
    for (int t = 0; t < NT; ++t) {
        const bool act = PH(t) < ntw;
        const bool isx = t + 1 < NT && !F32T(t + 1);
        Dma dx; dx.src = nullptr; dx.dst = lds; dx.sstep = 0; dx.dstep = 0;
        if (isx) { kv_tile(it.kv, PH(t + 1), kt, vt, sB); dx = (grp == 0) ? dma_K2(lds, (t + 1) & 1, kt, sB, wid, lane) : dma_V(lds, (t + 1) & 1, vt, sB, wid, lane); }
        if (!act && isx) { DMA_PIECE(dx, 0); DMA_PIECE(dx, 1); DMA_PIECE(dx, 2); DMA_PIECE(dx, 3); }
        if (act) {
            f32x16 p0 = f32x16{}, p1 = f32x16{};
            LAS unsigned char* kb = krd + (t & 1) * KBUF;
            __builtin_amdgcn_s_setprio(2);
            {
                const int kbv = (int)(uintptr_t)kb;
                bf16x8 K0, K1, K2, K3, K4;
#define KRD1(S_, i_) do { const int a_ = kbv + (((((i_) >> 1) ^ xh)) << 5); asm volatile("ds_read_b128 %0, %1 offset:%2" : "=&v"(S_) : "v"(a_), "i"(((i_) & 1) * 8192) : "memory"); } while (0)
                KRD1(K0, 0); KRD1(K1, 1); KRD1(K2, 2); KRD1(K3, 3); KRD1(K4, 4);
                LGKM(4); p0 = __builtin_amdgcn_mfma_f32_32x32x16_bf16(K0, qr[0], p0, 0, 0, 0); SBAR(); KRD1(K0, 5);
                LGKM(4); p1 = __builtin_amdgcn_mfma_f32_32x32x16_bf16(K1, qr[0], p1, 0, 0, 0); SBAR(); KRD1(K1, 6);
                LGKM(4); p0 = __builtin_amdgcn_mfma_f32_32x32x16_bf16(K2, qr[1], p0, 0, 0, 0); SBAR(); KRD1(K2, 7);
                LGKM(4); p1 = __builtin_amdgcn_mfma_f32_32x32x16_bf16(K3, qr[1], p1, 0, 0, 0); SBAR(); KRD1(K3, 8); if (isx) DMA_PIECE(dx, 0);
                LGKM(4); p0 = __builtin_amdgcn_mfma_f32_32x32x16_bf16(K4, qr[2], p0, 0, 0, 0); SBAR(); KRD1(K4, 9);
                LGKM(4); p1 = __builtin_amdgcn_mfma_f32_32x32x16_bf16(K0, qr[2], p1, 0, 0, 0); SBAR(); KRD1(K0, 10);
                LGKM(4); p0 = __builtin_amdgcn_mfma_f32_32x32x16_bf16(K1, qr[3], p0, 0, 0, 0); SBAR(); KRD1(K1, 11);
                LGKM(4); p1 = __builtin_amdgcn_mfma_f32_32x32x16_bf16(K2, qr[3], p1, 0, 0, 0); SBAR(); KRD1(K2, 12); if (isx) DMA_PIECE(dx, 1);
                LGKM(4); p0 = __builtin_amdgcn_mfma_f32_32x32x16_bf16(K3, qr[4], p0, 0, 0, 0); SBAR(); KRD1(K3, 13);
                LGKM(4); p1 = __builtin_amdgcn_mfma_f32_32x32x16_bf16(K4, qr[4], p1, 0, 0, 0); SBAR(); KRD1(K4, 14);
                LGKM(4); p0 = __builtin_amdgcn_mfma_f32_32x32x16_bf16(K0, qr[5], p0, 0, 0, 0); SBAR(); KRD1(K0, 15);
                LGKM(4); p1 = __builtin_amdgcn_mfma_f32_32x32x16_bf16(K1, qr[5], p1, 0, 0, 0); if (isx) DMA_PIECE(dx, 2);
                LGKM(3); p0 = __builtin_amdgcn_mfma_f32_32x32x16_bf16(K2, qr[6], p0, 0, 0, 0);
                LGKM(2); p1 = __builtin_amdgcn_mfma_f32_32x32x16_bf16(K3, qr[6], p1, 0, 0, 0);
                LGKM(1); p0 = __builtin_amdgcn_mfma_f32_32x32x16_bf16(K4, qr[7], p0, 0, 0, 0);
                LGKM(0); p1 = __builtin_amdgcn_mfma_f32_32x32x16_bf16(K0, qr[7], p1, 0, 0, 0); if (isx) DMA_PIECE(dx, 3);
#undef KRD1
            }
            __builtin_amdgcn_s_setprio(0);
            float pmax = p0[0];
#pragma unroll
            for (int r = 1; r < 16; ++r) pmax = fmaxf(pmax, p0[r]);
#pragma unroll
            for (int r = 0; r < 16; ++r) pmax = fmaxf(pmax, p1[r]);
            { auto rr = __builtin_amdgcn_permlane32_swap(__float_as_uint(pmax), __float_as_uint(pmax), false, false);
              pmax = fmaxf(__uint_as_float(rr[0]), __uint_as_float(rr[1])); }
            float mn, alpha;
            if (__builtin_expect(__all((pmax - m_reg) * DSCALE <= DTHR), 1)) { mn = m_reg; alpha = 1.f; }
            else { mn = fmaxf(m_reg, pmax); alpha = __builtin_amdgcn_exp2f((m_reg - mn) * DC2); m_reg = mn; }
            const float mnL = -mn * DC2;
            float ps = 0.f;
#pragma unroll
            for (int r = 0; r < 16; ++r) { p0[r] = __builtin_amdgcn_exp2f(fmaf(p0[r], DC2, mnL)); ps += p0[r]; }
#pragma unroll
            for (int r = 0; r < 16; ++r) { p1[r] = __builtin_amdgcn_exp2f(fmaf(p1[r], DC2, mnL)); ps += p1[r]; }
            { auto rr = __builtin_amdgcn_permlane32_swap(__float_as_uint(ps), __float_as_uint(ps), false, false);
              ps = __uint_as_float(rr[0]) + __uint_as_float(rr[1]); }
            l_reg = l_reg * alpha + ps;
            PK4(p0, 0, pa0); PK4(p0, 8, pa1); PK4(p1, 0, pa2); PK4(p1, 8, pa3);
            if (__any(alpha < 1.f)) {
                if (hi == 0) al_l[r32] = alpha;
                asm volatile("s_waitcnt lgkmcnt(0)" ::: "memory");
#pragma unroll
                for (int r = 0; r < 16; ++r) { const float a = al_l[crow(r, hi)];
#pragma unroll
                    for (int d0 = 0; d0 < 8; ++d0) o[d0][r] *= a; }
            }
        }
        WAIT_BAR(isx);
        const int ty = (grp == 0) ? t + 1 : t + 2;
        const bool isy = ty < NT && !F32T(ty);
        Dma dy; dy.src = nullptr; dy.dst = lds; dy.sstep = 0; dy.dstep = 0;
        if (isy) { if (grp == 0) { kv_tile(it.kv, PH(t + 1), kt, vt, sB); dy = dma_V(lds, (t + 1) & 1, vt, sB, wid, lane); } else { kv_tile(it.kv, PH(t + 2), kt, vt, sB); dy = dma_K2(lds, t & 1, kt, sB, wid, lane); } }
        if (!act && isy) { DMA_PIECE(dy, 0); DMA_PIECE(dy, 1); DMA_PIECE(dy, 2); DMA_PIECE(dy, 3); }
        if (act) {
            const int vb = vb0 + (t & 1) * VBUF;
            __builtin_amdgcn_s_setprio(1);
            s16x4 F0l, F0h, F1l, F1h, F2l, F2h, F3l, F3h, F4l, F4h, F5l, F5h, F6l, F6h, F7l, F7h;
            TRRD(F0l, vb, v_rd_off(0, 0, 0)); TRRD(F0h, vb, v_rd_off(0, 0, 1)); TRRD(F1l, vb, v_rd_off(0, 1, 0)); TRRD(F1h, vb, v_rd_off(0, 1, 1)); TRRD(F2l, vb, v_rd_off(0, 2, 0)); TRRD(F2h, vb, v_rd_off(0, 2, 1)); TRRD(F3l, vb, v_rd_off(0, 3, 0)); TRRD(F3h, vb, v_rd_off(0, 3, 1)); TRRD(F4l, vb, v_rd_off(1, 0, 0)); TRRD(F4h, vb, v_rd_off(1, 0, 1)); TRRD(F5l, vb, v_rd_off(1, 1, 0)); TRRD(F5h, vb, v_rd_off(1, 1, 1)); TRRD(F6l, vb, v_rd_off(1, 2, 0)); TRRD(F6h, vb, v_rd_off(1, 2, 1)); TRRD(F7l, vb, v_rd_off(1, 3, 0)); TRRD(F7h, vb, v_rd_off(1, 3, 1));
            LGKM(14); o[0] = __builtin_amdgcn_mfma_f32_32x32x16_bf16(pa0, (bf16x8){F0l[0], F0l[1], F0l[2], F0l[3], F0h[0], F0h[1], F0h[2], F0h[3]}, o[0], 0, 0, 0); SBAR(); TRRD(F0l, vb, v_rd_off(2, 0, 0)); TRRD(F0h, vb, v_rd_off(2, 0, 1));
            LGKM(14); o[0] = __builtin_amdgcn_mfma_f32_32x32x16_bf16(pa1, (bf16x8){F1l[0], F1l[1], F1l[2], F1l[3], F1h[0], F1h[1], F1h[2], F1h[3]}, o[0], 0, 0, 0); SBAR(); TRRD(F1l, vb, v_rd_off(2, 1, 0)); TRRD(F1h, vb, v_rd_off(2, 1, 1));
            LGKM(14); o[0] = __builtin_amdgcn_mfma_f32_32x32x16_bf16(pa2, (bf16x8){F2l[0], F2l[1], F2l[2], F2l[3], F2h[0], F2h[1], F2h[2], F2h[3]}, o[0], 0, 0, 0); SBAR(); TRRD(F2l, vb, v_rd_off(2, 2, 0)); TRRD(F2h, vb, v_rd_off(2, 2, 1));
            LGKM(14); o[0] = __builtin_amdgcn_mfma_f32_32x32x16_bf16(pa3, (bf16x8){F3l[0], F3l[1], F3l[2], F3l[3], F3h[0], F3h[1], F3h[2], F3h[3]}, o[0], 0, 0, 0); SBAR(); TRRD(F3l, vb, v_rd_off(2, 3, 0)); TRRD(F3h, vb, v_rd_off(2, 3, 1));
            LGKM(14); o[1] = __builtin_amdgcn_mfma_f32_32x32x16_bf16(pa0, (bf16x8){F4l[0], F4l[1], F4l[2], F4l[3], F4h[0], F4h[1], F4h[2], F4h[3]}, o[1], 0, 0, 0); SBAR(); TRRD(F4l, vb, v_rd_off(3, 0, 0)); TRRD(F4h, vb, v_rd_off(3, 0, 1));
            LGKM(14); o[1] = __builtin_amdgcn_mfma_f32_32x32x16_bf16(pa1, (bf16x8){F5l[0], F5l[1], F5l[2], F5l[3], F5h[0], F5h[1], F5h[2], F5h[3]}, o[1], 0, 0, 0); SBAR(); TRRD(F5l, vb, v_rd_off(3, 1, 0)); TRRD(F5h, vb, v_rd_off(3, 1, 1)); if (isy) DMA_PIECE(dy, 0);
            LGKM(14); o[1] = __builtin_amdgcn_mfma_f32_32x32x16_bf16(pa2, (bf16x8){F6l[0], F6l[1], F6l[2], F6l[3], F6h[0], F6h[1], F6h[2], F6h[3]}, o[1], 0, 0, 0); SBAR(); TRRD(F6l, vb, v_rd_off(3, 2, 0)); TRRD(F6h, vb, v_rd_off(3, 2, 1));
            LGKM(14); o[1] = __builtin_amdgcn_mfma_f32_32x32x16_bf16(pa3, (bf16x8){F7l[0], F7l[1], F7l[2], F7l[3], F7h[0], F7h[1], F7h[2], F7h[3]}, o[1], 0, 0, 0); SBAR(); TRRD(F7l, vb, v_rd_off(3, 3, 0)); TRRD(F7h, vb, v_rd_off(3, 3, 1));
            LGKM(14); o[2] = __builtin_amdgcn_mfma_f32_32x32x16_bf16(pa0, (bf16x8){F0l[0], F0l[1], F0l[2], F0l[3], F0h[0], F0h[1], F0h[2], F0h[3]}, o[2], 0, 0, 0); SBAR(); TRRD(F0l, vb, v_rd_off(4, 0, 0)); TRRD(F0h, vb, v_rd_off(4, 0, 1));
            LGKM(14); o[2] = __builtin_amdgcn_mfma_f32_32x32x16_bf16(pa1, (bf16x8){F1l[0], F1l[1], F1l[2], F1l[3], F1h[0], F1h[1], F1h[2], F1h[3]}, o[2], 0, 0, 0); SBAR(); TRRD(F1l, vb, v_rd_off(4, 1, 0)); TRRD(F1h, vb, v_rd_off(4, 1, 1));
            LGKM(14); o[2] = __builtin_amdgcn_mfma_f32_32x32x16_bf16(pa2, (bf16x8){F2l[0], F2l[1], F2l[2], F2l[3], F2h[0], F2h[1], F2h[2], F2h[3]}, o[2], 0, 0, 0); SBAR(); TRRD(F2l, vb, v_rd_off(4, 2, 0)); TRRD(F2h, vb, v_rd_off(4, 2, 1));
            LGKM(14); o[2] = __builtin_amdgcn_mfma_f32_32x32x16_bf16(pa3, (bf16x8){F3l[0], F3l[1], F3l[2], F3l[3], F3h[0], F3h[1], F3h[2], F3h[3]}, o[2], 0, 0, 0); SBAR(); TRRD(F3l, vb, v_rd_off(4, 3, 0)); TRRD(F3h, vb, v_rd_off(4, 3, 1));
            LGKM(14); o[3] = __builtin_amdgcn_mfma_f32_32x32x16_bf16(pa0, (bf16x8){F4l[0], F4l[1], F4l[2], F4l[3], F4h[0], F4h[1], F4h[2], F4h[3]}, o[3], 0, 0, 0); SBAR(); TRRD(F4l, vb, v_rd_off(5, 0, 0)); TRRD(F4h, vb, v_rd_off(5, 0, 1));
            LGKM(14); o[3] = __builtin_amdgcn_mfma_f32_32x32x16_bf16(pa1, (bf16x8){F5l[0], F5l[1], F5l[2], F5l[3], F5h[0], F5h[1], F5h[2], F5h[3]}, o[3], 0, 0, 0); SBAR(); TRRD(F5l, vb, v_rd_off(5, 1, 0)); TRRD(F5h, vb, v_rd_off(5, 1, 1)); if (isy) DMA_PIECE(dy, 1);
            LGKM(14); o[3] = __builtin_amdgcn_mfma_f32_32x32x16_bf16(pa2, (bf16x8){F6l[0], F6l[1], F6l[2], F6l[3], F6h[0], F6h[1], F6h[2], F6h[3]}, o[3], 0, 0, 0); SBAR(); TRRD(F6l, vb, v_rd_off(5, 2, 0)); TRRD(F6h, vb, v_rd_off(5, 2, 1));
            LGKM(14); o[3] = __builtin_amdgcn_mfma_f32_32x32x16_bf16(pa3, (bf16x8){F7l[0], F7l[1], F7l[2], F7l[3], F7h[0], F7h[1], F7h[2], F7h[3]}, o[3], 0, 0, 0); SBAR(); TRRD(F7l, vb, v_rd_off(5, 3, 0)); TRRD(F7h, vb, v_rd_off(5, 3, 1));
            LGKM(14); o[4] = __builtin_amdgcn_mfma_f32_32x32x16_bf16(pa0, (bf16x8){F0l[0], F0l[1], F0l[2], F0l[3], F0h[0], F0h[1], F0h[2], F0h[3]}, o[4], 0, 0, 0); SBAR(); TRRD(F0l, vb, v_rd_off(6, 0, 0)); TRRD(F0h, vb, v_rd_off(6, 0, 1));
            LGKM(14); o[4] = __builtin_amdgcn_mfma_f32_32x32x16_bf16(pa1, (bf16x8){F1l[0], F1l[1], F1l[2], F1l[3], F1h[0], F1h[1], F1h[2], F1h[3]}, o[4], 0, 0, 0); SBAR(); TRRD(F1l, vb, v_rd_off(6, 1, 0)); TRRD(F1h, vb, v_rd_off(6, 1, 1));
            LGKM(14); o[4] = __builtin_amdgcn_mfma_f32_32x32x16_bf16(pa2, (bf16x8){F2l[0], F2l[1], F2l[2], F2l[3], F2h[0], F2h[1], F2h[2], F2h[3]}, o[4], 0, 0, 0); SBAR(); TRRD(F2l, vb, v_rd_off(6, 2, 0)); TRRD(F2h, vb, v_rd_off(6, 2, 1));
            LGKM(14); o[4] = __builtin_amdgcn_mfma_f32_32x32x16_bf16(pa3, (bf16x8){F3l[0], F3l[1], F3l[2], F3l[3], F3h[0], F3h[1], F3h[2], F3h[3]}, o[4], 0, 0, 0); SBAR(); TRRD(F3l, vb, v_rd_off(6, 3, 0)); TRRD(F3h, vb, v_rd_off(6, 3, 1));
            LGKM(14); o[5] = __builtin_amdgcn_mfma_f32_32x32x16_bf16(pa0, (bf16x8){F4l[0], F4l[1], F4l[2], F4l[3], F4h[0], F4h[1], F4h[2], F4h[3]}, o[5], 0, 0, 0); SBAR(); TRRD(F4l, vb, v_rd_off(7, 0, 0)); TRRD(F4h, vb, v_rd_off(7, 0, 1));
            LGKM(14); o[5] = __builtin_amdgcn_mfma_f32_32x32x16_bf16(pa1, (bf16x8){F5l[0], F5l[1], F5l[2], F5l[3], F5h[0], F5h[1], F5h[2], F5h[3]}, o[5], 0, 0, 0); SBAR(); TRRD(F5l, vb, v_rd_off(7, 1, 0)); TRRD(F5h, vb, v_rd_off(7, 1, 1)); if (isy) DMA_PIECE(dy, 2);
            LGKM(14); o[5] = __builtin_amdgcn_mfma_f32_32x32x16_bf16(pa2, (bf16x8){F6l[0], F6l[1], F6l[2], F6l[3], F6h[0], F6h[1], F6h[2], F6h[3]}, o[5], 0, 0, 0); SBAR(); TRRD(F6l, vb, v_rd_off(7, 2, 0)); TRRD(F6h, vb, v_rd_off(7, 2, 1));
            LGKM(14); o[5] = __builtin_amdgcn_mfma_f32_32x32x16_bf16(pa3, (bf16x8){F7l[0], F7l[1], F7l[2], F7l[3], F7h[0], F7h[1], F7h[2], F7h[3]}, o[5], 0, 0, 0); SBAR(); TRRD(F7l, vb, v_rd_off(7, 3, 0)); TRRD(F7h, vb, v_rd_off(7, 3, 1));
            LGKM(14); o[6] = __builtin_amdgcn_mfma_f32_32x32x16_bf16(pa0, (bf16x8){F0l[0], F0l[1], F0l[2], F0l[3], F0h[0], F0h[1], F0h[2], F0h[3]}, o[6], 0, 0, 0);
            LGKM(12); o[6] = __builtin_amdgcn_mfma_f32_32x32x16_bf16(pa1, (bf16x8){F1l[0], F1l[1], F1l[2], F1l[3], F1h[0], F1h[1], F1h[2], F1h[3]}, o[6], 0, 0, 0);
            LGKM(10); o[6] = __builtin_amdgcn_mfma_f32_32x32x16_bf16(pa2, (bf16x8){F2l[0], F2l[1], F2l[2], F2l[3], F2h[0], F2h[1], F2h[2], F2h[3]}, o[6], 0, 0, 0);
            LGKM(8); o[6] = __builtin_amdgcn_mfma_f32_32x32x16_bf16(pa3, (bf16x8){F3l[0], F3l[1], F3l[2], F3l[3], F3h[0], F3h[1], F3h[2], F3h[3]}, o[6], 0, 0, 0);
            LGKM(6); o[7] = __builtin_amdgcn_mfma_f32_32x32x16_bf16(pa0, (bf16x8){F4l[0], F4l[1], F4l[2], F4l[3], F4h[0], F4h[1], F4h[2], F4h[3]}, o[7], 0, 0, 0);
            LGKM(4); o[7] = __builtin_amdgcn_mfma_f32_32x32x16_bf16(pa1, (bf16x8){F5l[0], F5l[1], F5l[2], F5l[3], F5h[0], F5h[1], F5h[2], F5h[3]}, o[7], 0, 0, 0); if (isy) DMA_PIECE(dy, 3);
            LGKM(2); o[7] = __builtin_amdgcn_mfma_f32_32x32x16_bf16(pa2, (bf16x8){F6l[0], F6l[1], F6l[2], F6l[3], F6h[0], F6h[1], F6h[2], F6h[3]}, o[7], 0, 0, 0);
            LGKM(0); o[7] = __builtin_amdgcn_mfma_f32_32x32x16_bf16(pa3, (bf16x8){F7l[0], F7l[1], F7l[2], F7l[3], F7h[0], F7h[1], F7h[2], F7h[3]}, o[7], 0, 0, 0);
            __builtin_amdgcn_s_setprio(0);
        }
        WAIT_BAR(isy);
    }
    if (grp == 0) WGBAR();
#undef ISSUE_K
#undef ISSUE_V
#undef PH
#undef F32T
    const int lane_e = __builtin_amdgcn_mbcnt_hi(~0u, __builtin_amdgcn_mbcnt_lo(~0u, 0u)), r32e = lane_e & 31, hie = lane_e >> 5;
    const bool active = ntw > 0;
    if (active) {
        if (hie == 0) li_l[r32e] = (grp == 0 ? 1.f : -lam) / l_reg;
        asm volatile("s_waitcnt lgkmcnt(0)" ::: "memory");
#pragma unroll
        for (int r = 0; r < 16; ++r) { const float a = li_l[crow(r, hie)];
#pragma unroll
            for (int d0 = 0; d0 < 8; ++d0) o[d0][r] *= a; }
        if (grp == 1) {
#pragma unroll
            for (int r = 0; r < 16; ++r) { LAS float* xp = (LAS float*)(lds + (wq * 32 + crow(r, hie)) * 1024) + r32e;
#pragma unroll
                for (int d0 = 0; d0 < 8; ++d0) xp[d0 * 32] = o[d0][r]; }
        }
    }
    asm volatile("s_waitcnt lgkmcnt(0)" ::: "memory"); WGBAR();
    if (active && grp == 0) {
        float sw[8];
        const float post = g_post[lidx];
#pragma unroll
        for (int d0 = 0; d0 < 8; ++d0) sw[d0] = subw[d0 * 32 + r32e] * post;
        const bf16_t* gp = it.q + 3072 + (size_t)(wq * 32) * NIN + lane_e * 4;
        bf16_t* op = it.o + (size_t)(wq * 32) * D + lane_e * 4;
        u32x2 gq[32];
#pragma unroll
        for (int rr = 0; rr < 32; ++rr) gq[rr] = *(const u32x2*)(gp + (size_t)rr * NIN);
#pragma unroll
        for (int r = 0; r < 16; ++r) {
            const int row = wq * 32 + crow(r, hie);
            LAS float* xp = (LAS float*)(lds + row * 1024) + r32e;
            float ssq = 0.f;
#pragma unroll
            for (int d0 = 0; d0 < 8; ++d0) { o[d0][r] += xp[d0 * 32]; ssq += o[d0][r] * o[d0][r]; }
            ssq = half_sum(ssq);
            const float rs = 1.0f / sqrtf(ssq * (1.0f / 256.0f) + EPS);
#pragma unroll
            for (int d0 = 0; d0 < 8; ++d0) xp[d0 * 32] = o[d0][r] * rs * sw[d0];
        }
#pragma unroll
        for (int rr = 0; rr < 32; ++rr) {
            const f32x4 t = *(const LAS f32x4*)(lds + (wq * 32 + rr) * 1024 + lane_e * 16);
            const float g0 = bf_lo(gq[rr][0]), g1 = bf_hi(gq[rr][0]), g2 = bf_lo(gq[rr][1]), g3 = bf_hi(gq[rr][1]);
            const u32x2 w = {cvtpk(t[0] * g0 / (1.0f + __expf(-g0)), t[1] * g1 / (1.0f + __expf(-g1))), cvtpk(t[2] * g2 / (1.0f + __expf(-g2)), t[3] * g3 / (1.0f + __expf(-g3)))};
            *(u32x2*)(op + (size_t)rr * D) = w;
        }
    }
    asm volatile("s_waitcnt vmcnt(0) lgkmcnt(0)" ::: "memory"); WGBAR();
}

struct SItem { const bf16_t* q; KVSrc kv; int P0, nrows, jstart; bf16_t* o; const float* kf; const float* vf; };
__device__ __forceinline__ void issue_K1(LAS unsigned char* lds, int buf, const char* kt, int strideB, int wid, int lane) {
    const int rowL = 2 * wid + (lane >> 5);
    const char* src = kt + (size_t)rowL * strideB + (((lane & 31) ^ rowL) << 4);
    LAS unsigned char* dst = lds + buf * KBUF + wid * 1024;
#pragma unroll
    for (int jj = 0; jj < 4; ++jj) GLDS(src + (size_t)jj * 16 * strideB, dst + jj * 8192);
}
__device__ __forceinline__ void issue_V16(LAS unsigned char* lds, int buf, const char* vt, int strideB, int wid, int lane) {
    const int rowL = 2 * wid + (lane >> 5), c16 = lane & 31;
    const char* src = vt + (size_t)rowL * strideB + ((((c16 >> 1) ^ (rowL & 7))) << 5) + ((c16 & 1) << 4);
    LAS unsigned char* dst = lds + LV0 + buf * VBUF + wid * 1024;
#pragma unroll
    for (int jj = 0; jj < 4; ++jj) GLDS(src + (size_t)jj * 16 * strideB, dst + jj * 8192);
}
__device__ __forceinline__ void load_tile_f32(LAS unsigned char* lds, int buf, const float* kf, const float* vf, int tid) {
    const int w = tid >> 6, L = tid & 63, c = L >> 1, hf = (L & 1) * 8;
    {   const float* p = kf + (size_t)(8 * w) * 1024 + L * 4; f32x4 a[8];
#pragma unroll
        for (int i = 0; i < 8; ++i) a[i] = __builtin_nontemporal_load((const f32x4*)(p + (size_t)i * 1024));
#pragma unroll
        for (int i = 0; i < 8; ++i) { const int row = 8 * w + i; const u32x2 v = {cvtpk(a[i][0], a[i][1]), cvtpk(a[i][2], a[i][3])};
            *(LAS u32x2*)(lds + buf * KBUF + row * 512 + ((c ^ (row & 15)) << 4) + hf) = v; } }
    {   const float* p = vf + (size_t)(8 * w) * 1024 + L * 4; f32x4 a[8];
#pragma unroll
        for (int i = 0; i < 8; ++i) a[i] = __builtin_nontemporal_load((const f32x4*)(p + (size_t)i * 1024));
#pragma unroll
        for (int i = 0; i < 8; ++i) { const int row = 8 * w + i; const u32x2 v = {cvtpk(a[i][0], a[i][1]), cvtpk(a[i][2], a[i][3])};
            *(LAS u32x2*)(lds + LV0 + buf * VBUF + row * 512 + ((((c >> 1) ^ (row & 7))) << 5) + ((c & 1) << 4) + hf) = v; } }
}
constexpr float LOG2E = 1.4426950408889634f, LN2 = 0.6931471805599453f;

__device__ __forceinline__ void sb_item(const SItem& it, LAS unsigned char* lds) {
    int tid = threadIdx.x; asm volatile("" : "+v"(tid));
    const int wid = __builtin_amdgcn_readfirstlane(tid >> 6), lane = tid & 63, j16 = lane & 15, q4 = lane >> 4;
    const int dh = wid >> 2, wq = wid & 3;
    const bool active = wq * 32 < it.nrows;
    volatile LAS unsigned* flags = (volatile LAS unsigned*)(lds + LDS_MISC + 64);
    bf16x8 qr[8];
    if (active) { const bf16_t* qp = it.q + (size_t)(wq * 32 + dh * 16 + j16) * NIN + q4 * 8;
#pragma unroll
        for (int ds = 0; ds < 8; ++ds) qr[ds] = *(const bf16x8*)(qp + ds * 32); }
    else {
#pragma unroll
        for (int ds = 0; ds < 8; ++ds) qr[ds] = (bf16x8){0, 0, 0, 0, 0, 0, 0, 0}; }
    f32x4 o[16];
#pragma unroll
    for (int cb = 0; cb < 16; ++cb) o[cb] = (f32x4){0.f, 0.f, 0.f, 0.f};
    float C = 0.f;
    const int P0w = it.P0 + 32 * wq + 16 * dh, jw = P0w >> 6, lim = (P0w & 63) + j16;
    const int xh2 = j16 >> 2;
    LAS unsigned char* krd = lds + j16 * 512 + ((q4 ^ (j16 & 3)) << 4);
    const int rx = 4 * (q4 & 1) + ((lane >> 2) & 3);
    const int vb0 = (int)(uintptr_t)(lds + LV0) + (4 * q4 + ((lane >> 2) & 3)) * 512 + 8 * (lane & 3);
    const char* kt; const char* vt; int sB;
    bool done = !active;
    kv_tile(it.kv, it.jstart, kt, vt, sB); issue_K1(lds, 0, kt, sB, wid, lane); issue_V16(lds, 0, vt, sB, wid, lane);
    asm volatile("s_waitcnt vmcnt(0)" ::: "memory"); WGBAR();
    for (int itn = 0;; ++itn) {
        const int j = it.jstart - itn, b = itn & 1;
        const bool nxt_f32 = j > 0 && it.kf != nullptr && (j - 1) < it.kv.nsplit;
        if (j > 0 && !nxt_f32) { kv_tile(it.kv, j - 1, kt, vt, sB); issue_K1(lds, b ^ 1, kt, sB, wid, lane); issue_V16(lds, b ^ 1, vt, sB, wid, lane); }
        if (!done && j <= jw) {
            const bool diag = (j == jw);
            f32x4 st[4];
#pragma unroll
            for (int kb = 0; kb < 4; ++kb) st[kb] = (f32x4){0.f, 0.f, 0.f, 0.f};
            const int kbv = (int)(uintptr_t)(krd + b * KBUF);
            bf16x8 K0, K1, K2, K3, K4, K5;
#define KRD1(S_, i_) do { const int a_ = kbv + ((((((i_) & 7) & 3) ^ xh2)) << 6); asm volatile("ds_read_b128 %0, %1 offset:%2" : "=&v"(S_) : "v"(a_), "i"(((i_) >> 3) * 8192 + (((i_) & 7) >> 2) * 256) : "memory"); } while (0)
            KRD1(K0, 0); KRD1(K1, 1); KRD1(K2, 2); KRD1(K3, 3); KRD1(K4, 4); KRD1(K5, 5);
            LGKM(5); st[0] = __builtin_amdgcn_mfma_f32_16x16x32_bf16(K0, qr[0], st[0], 0, 0, 0); SBAR(); KRD1(K0, 6);
            LGKM(5); st[0] = __builtin_amdgcn_mfma_f32_16x16x32_bf16(K1, qr[1], st[0], 0, 0, 0); SBAR(); KRD1(K1, 7);
            LGKM(5); st[0] = __builtin_amdgcn_mfma_f32_16x16x32_bf16(K2, qr[2], st[0], 0, 0, 0); SBAR(); KRD1(K2, 8);
            LGKM(5); st[0] = __builtin_amdgcn_mfma_f32_16x16x32_bf16(K3, qr[3], st[0], 0, 0, 0); SBAR(); KRD1(K3, 9);
            LGKM(5); st[0] = __builtin_amdgcn_mfma_f32_16x16x32_bf16(K4, qr[4], st[0], 0, 0, 0); SBAR(); KRD1(K4, 10);
            LGKM(5); st[0] = __builtin_amdgcn_mfma_f32_16x16x32_bf16(K5, qr[5], st[0], 0, 0, 0); SBAR(); KRD1(K5, 11);
            LGKM(5); st[0] = __builtin_amdgcn_mfma_f32_16x16x32_bf16(K0, qr[6], st[0], 0, 0, 0); SBAR(); KRD1(K0, 12);
            LGKM(5); st[0] = __builtin_amdgcn_mfma_f32_16x16x32_bf16(K1, qr[7], st[0], 0, 0, 0); SBAR(); KRD1(K1, 13);
            LGKM(5); st[1] = __builtin_amdgcn_mfma_f32_16x16x32_bf16(K2, qr[0], st[1], 0, 0, 0); SBAR(); KRD1(K2, 14);
            LGKM(5); st[1] = __builtin_amdgcn_mfma_f32_16x16x32_bf16(K3, qr[1], st[1], 0, 0, 0); SBAR(); KRD1(K3, 15);
            LGKM(5); st[1] = __builtin_amdgcn_mfma_f32_16x16x32_bf16(K4, qr[2], st[1], 0, 0, 0); SBAR(); KRD1(K4, 16);
            LGKM(5); st[1] = __builtin_amdgcn_mfma_f32_16x16x32_bf16(K5, qr[3], st[1], 0, 0, 0); SBAR(); KRD1(K5, 17);
            LGKM(5); st[1] = __builtin_amdgcn_mfma_f32_16x16x32_bf16(K0, qr[4], st[1], 0, 0, 0); SBAR(); KRD1(K0, 18);
            LGKM(5); st[1] = __builtin_amdgcn_mfma_f32_16x16x32_bf16(K1, qr[5], st[1], 0, 0, 0); SBAR(); KRD1(K1, 19);
            LGKM(5); st[1] = __builtin_amdgcn_mfma_f32_16x16x32_bf16(K2, qr[6], st[1], 0, 0, 0); SBAR(); KRD1(K2, 20);
            LGKM(5); st[1] = __builtin_amdgcn_mfma_f32_16x16x32_bf16(K3, qr[7], st[1], 0, 0, 0); SBAR(); KRD1(K3, 21);
            LGKM(5); st[2] = __builtin_amdgcn_mfma_f32_16x16x32_bf16(K4, qr[0], st[2], 0, 0, 0); SBAR(); KRD1(K4, 22);
            LGKM(5); st[2] = __builtin_amdgcn_mfma_f32_16x16x32_bf16(K5, qr[1], st[2], 0, 0, 0); SBAR(); KRD1(K5, 23);
            LGKM(5); st[2] = __builtin_amdgcn_mfma_f32_16x16x32_bf16(K0, qr[2], st[2], 0, 0, 0); SBAR(); KRD1(K0, 24);
            LGKM(5); st[2] = __builtin_amdgcn_mfma_f32_16x16x32_bf16(K1, qr[3], st[2], 0, 0, 0); SBAR(); KRD1(K1, 25);
            LGKM(5); st[2] = __builtin_amdgcn_mfma_f32_16x16x32_bf16(K2, qr[4], st[2], 0, 0, 0); SBAR(); KRD1(K2, 26);
            LGKM(5); st[2] = __builtin_amdgcn_mfma_f32_16x16x32_bf16(K3, qr[5], st[2], 0, 0, 0); SBAR(); KRD1(K3, 27);
            LGKM(5); st[2] = __builtin_amdgcn_mfma_f32_16x16x32_bf16(K4, qr[6], st[2], 0, 0, 0); SBAR(); KRD1(K4, 28);
            LGKM(5); st[2] = __builtin_amdgcn_mfma_f32_16x16x32_bf16(K5, qr[7], st[2], 0, 0, 0); SBAR(); KRD1(K5, 29);
            LGKM(5); st[3] = __builtin_amdgcn_mfma_f32_16x16x32_bf16(K0, qr[0], st[3], 0, 0, 0); SBAR(); KRD1(K0, 30);
            LGKM(5); st[3] = __builtin_amdgcn_mfma_f32_16x16x32_bf16(K1, qr[1], st[3], 0, 0, 0); SBAR(); KRD1(K1, 31);
            LGKM(5); st[3] = __builtin_amdgcn_mfma_f32_16x16x32_bf16(K2, qr[2], st[3], 0, 0, 0);
            LGKM(4); st[3] = __builtin_amdgcn_mfma_f32_16x16x32_bf16(K3, qr[3], st[3], 0, 0, 0);
            LGKM(3); st[3] = __builtin_amdgcn_mfma_f32_16x16x32_bf16(K4, qr[4], st[3], 0, 0, 0);
            LGKM(2); st[3] = __builtin_amdgcn_mfma_f32_16x16x32_bf16(K5, qr[5], st[3], 0, 0, 0);
            LGKM(1); st[3] = __builtin_amdgcn_mfma_f32_16x16x32_bf16(K0, qr[6], st[3], 0, 0, 0);
            LGKM(0); st[3] = __builtin_amdgcn_mfma_f32_16x16x32_bf16(K1, qr[7], st[3], 0, 0, 0);
#undef KRD1
            f32x4 L[4];
#pragma unroll
            for (int kb = 0; kb < 4; ++kb)
#pragma unroll
                for (int e = 0; e < 4; ++e) { const float z = st[kb][e]; const float t_ = __builtin_amdgcn_exp2f(-fabsf(z) * LOG2E); L[kb][e] = -(fmaxf(z, 0.f) + LN2 * __builtin_amdgcn_logf(1.0f + t_)); }
            if (diag) {
#pragma unroll
                for (int kb = 0; kb < 4; ++kb)
#pragma unroll
                    for (int e = 0; e < 4; ++e) if (16 * kb + 4 * q4 + e >= lim) { L[kb][e] = 0.f; st[kb][e] = -1e30f; }
            }
            float run = C;
#pragma unroll
            for (int kb = 3; kb >= 0; --kb) {
                L[kb][2] += L[kb][3]; L[kb][1] += L[kb][2]; L[kb][0] += L[kb][1];
                const float g = L[kb][0];
                const float p1 = xor_lane<16>(g);
                const float pair = g + p1;
                float opair; { auto rr = __builtin_amdgcn_permlane32_swap(__float_as_uint(pair), __float_as_uint(pair), false, false); opair = (q4 & 2) ? __uint_as_float(rr[0]) : __uint_as_float(rr[1]); }
                const float off = run + ((q4 & 1) ? 0.f : p1) + ((q4 & 2) ? 0.f : opair);
#pragma unroll
                for (int e = 0; e < 4; ++e) st[kb][e] = __builtin_amdgcn_exp2f((st[kb][e] + L[kb][e] + off) * LOG2E);
                run += pair + opair;
            }
            C = run;
            bf16x8 pa[2];
#pragma unroll
            for (int s = 0; s < 2; ++s) { u32x4 w = {cvtpk(st[2 * s][0], st[2 * s][1]), cvtpk(st[2 * s][2], st[2 * s][3]), cvtpk(st[2 * s + 1][0], st[2 * s + 1][1]), cvtpk(st[2 * s + 1][2], st[2 * s + 1][3])};
                pa[s] = *reinterpret_cast<bf16x8*>(&w); }
            const int vbt = vb0 + b * VBUF;
            s16x4 F0l, F0h, F1l, F1h, F2l, F2h, F3l, F3h, F4l, F4h, F5l, F5h, F6l, F6h, F7l, F7h;
#define VRD1(S_, i_) do { const int a_ = vbt + (((((i_) >> 1) & 7) ^ rx) << 5); asm volatile("ds_read_b64_tr_b16 %0, %2 offset:%3\n\tds_read_b64_tr_b16 %1, %2 offset:%4" : "=&v"(S_##l), "=&v"(S_##h) : "v"(a_), "i"(((i_) >> 4) * 256 + ((i_) & 1) * 16384), "i"(((i_) >> 4) * 256 + ((i_) & 1) * 16384 + 8192) : "memory"); } while (0)
            VRD1(F0, 0); VRD1(F1, 1); VRD1(F2, 2); VRD1(F3, 3); VRD1(F4, 4); VRD1(F5, 5); VRD1(F6, 6); VRD1(F7, 7);
            LGKM(14); o[0] = __builtin_amdgcn_mfma_f32_16x16x32_bf16(pa[0], (bf16x8){F0l[0], F0l[1], F0l[2], F0l[3], F0h[0], F0h[1], F0h[2], F0h[3]}, o[0], 0, 0, 0); SBAR(); VRD1(F0, 8);
            LGKM(14); o[0] = __builtin_amdgcn_mfma_f32_16x16x32_bf16(pa[1], (bf16x8){F1l[0], F1l[1], F1l[2], F1l[3], F1h[0], F1h[1], F1h[2], F1h[3]}, o[0], 0, 0, 0); SBAR(); VRD1(F1, 9);
            LGKM(14); o[1] = __builtin_amdgcn_mfma_f32_16x16x32_bf16(pa[0], (bf16x8){F2l[0], F2l[1], F2l[2], F2l[3], F2h[0], F2h[1], F2h[2], F2h[3]}, o[1], 0, 0, 0); SBAR(); VRD1(F2, 10);
            LGKM(14); o[1] = __builtin_amdgcn_mfma_f32_16x16x32_bf16(pa[1], (bf16x8){F3l[0], F3l[1], F3l[2], F3l[3], F3h[0], F3h[1], F3h[2], F3h[3]}, o[1], 0, 0, 0); SBAR(); VRD1(F3, 11);
            LGKM(14); o[2] = __builtin_amdgcn_mfma_f32_16x16x32_bf16(pa[0], (bf16x8){F4l[0], F4l[1], F4l[2], F4l[3], F4h[0], F4h[1], F4h[2], F4h[3]}, o[2], 0, 0, 0); SBAR(); VRD1(F4, 12);
            LGKM(14); o[2] = __builtin_amdgcn_mfma_f32_16x16x32_bf16(pa[1], (bf16x8){F5l[0], F5l[1], F5l[2], F5l[3], F5h[0], F5h[1], F5h[2], F5h[3]}, o[2], 0, 0, 0); SBAR(); VRD1(F5, 13);
            LGKM(14); o[3] = __builtin_amdgcn_mfma_f32_16x16x32_bf16(pa[0], (bf16x8){F6l[0], F6l[1], F6l[2], F6l[3], F6h[0], F6h[1], F6h[2], F6h[3]}, o[3], 0, 0, 0); SBAR(); VRD1(F6, 14);
            LGKM(14); o[3] = __builtin_amdgcn_mfma_f32_16x16x32_bf16(pa[1], (bf16x8){F7l[0], F7l[1], F7l[2], F7l[3], F7h[0], F7h[1], F7h[2], F7h[3]}, o[3], 0, 0, 0); SBAR(); VRD1(F7, 15);
            LGKM(14); o[4] = __builtin_amdgcn_mfma_f32_16x16x32_bf16(pa[0], (bf16x8){F0l[0], F0l[1], F0l[2], F0l[3], F0h[0], F0h[1], F0h[2], F0h[3]}, o[4], 0, 0, 0); SBAR(); VRD1(F0, 16);
            LGKM(14); o[4] = __builtin_amdgcn_mfma_f32_16x16x32_bf16(pa[1], (bf16x8){F1l[0], F1l[1], F1l[2], F1l[3], F1h[0], F1h[1], F1h[2], F1h[3]}, o[4], 0, 0, 0); SBAR(); VRD1(F1, 17);
            LGKM(14); o[5] = __builtin_amdgcn_mfma_f32_16x16x32_bf16(pa[0], (bf16x8){F2l[0], F2l[1], F2l[2], F2l[3], F2h[0], F2h[1], F2h[2], F2h[3]}, o[5], 0, 0, 0); SBAR(); VRD1(F2, 18);
            LGKM(14); o[5] = __builtin_amdgcn_mfma_f32_16x16x32_bf16(pa[1], (bf16x8){F3l[0], F3l[1], F3l[2], F3l[3], F3h[0], F3h[1], F3h[2], F3h[3]}, o[5], 0, 0, 0); SBAR(); VRD1(F3, 19);
            LGKM(14); o[6] = __builtin_amdgcn_mfma_f32_16x16x32_bf16(pa[0], (bf16x8){F4l[0], F4l[1], F4l[2], F4l[3], F4h[0], F4h[1], F4h[2], F4h[3]}, o[6], 0, 0, 0); SBAR(); VRD1(F4, 20);
            LGKM(14); o[6] = __builtin_amdgcn_mfma_f32_16x16x32_bf16(pa[1], (bf16x8){F5l[0], F5l[1], F5l[2], F5l[3], F5h[0], F5h[1], F5h[2], F5h[3]}, o[6], 0, 0, 0); SBAR(); VRD1(F5, 21);
            LGKM(14); o[7] = __builtin_amdgcn_mfma_f32_16x16x32_bf16(pa[0], (bf16x8){F6l[0], F6l[1], F6l[2], F6l[3], F6h[0], F6h[1], F6h[2], F6h[3]}, o[7], 0, 0, 0); SBAR(); VRD1(F6, 22);
            LGKM(14); o[7] = __builtin_amdgcn_mfma_f32_16x16x32_bf16(pa[1], (bf16x8){F7l[0], F7l[1], F7l[2], F7l[3], F7h[0], F7h[1], F7h[2], F7h[3]}, o[7], 0, 0, 0); SBAR(); VRD1(F7, 23);
            LGKM(14); o[8] = __builtin_amdgcn_mfma_f32_16x16x32_bf16(pa[0], (bf16x8){F0l[0], F0l[1], F0l[2], F0l[3], F0h[0], F0h[1], F0h[2], F0h[3]}, o[8], 0, 0, 0); SBAR(); VRD1(F0, 24);
            LGKM(14); o[8] = __builtin_amdgcn_mfma_f32_16x16x32_bf16(pa[1], (bf16x8){F1l[0], F1l[1], F1l[2], F1l[3], F1h[0], F1h[1], F1h[2], F1h[3]}, o[8], 0, 0, 0); SBAR(); VRD1(F1, 25);
            LGKM(14); o[9] = __builtin_amdgcn_mfma_f32_16x16x32_bf16(pa[0], (bf16x8){F2l[0], F2l[1], F2l[2], F2l[3], F2h[0], F2h[1], F2h[2], F2h[3]}, o[9], 0, 0, 0); SBAR(); VRD1(F2, 26);
            LGKM(14); o[9] = __builtin_amdgcn_mfma_f32_16x16x32_bf16(pa[1], (bf16x8){F3l[0], F3l[1], F3l[2], F3l[3], F3h[0], F3h[1], F3h[2], F3h[3]}, o[9], 0, 0, 0); SBAR(); VRD1(F3, 27);
            LGKM(14); o[10] = __builtin_amdgcn_mfma_f32_16x16x32_bf16(pa[0], (bf16x8){F4l[0], F4l[1], F4l[2], F4l[3], F4h[0], F4h[1], F4h[2], F4h[3]}, o[10], 0, 0, 0); SBAR(); VRD1(F4, 28);
            LGKM(14); o[10] = __builtin_amdgcn_mfma_f32_16x16x32_bf16(pa[1], (bf16x8){F5l[0], F5l[1], F5l[2], F5l[3], F5h[0], F5h[1], F5h[2], F5h[3]}, o[10], 0, 0, 0); SBAR(); VRD1(F5, 29);
            LGKM(14); o[11] = __builtin_amdgcn_mfma_f32_16x16x32_bf16(pa[0], (bf16x8){F6l[0], F6l[1], F6l[2], F6l[3], F6h[0], F6h[1], F6h[2], F6h[3]}, o[11], 0, 0, 0); SBAR(); VRD1(F6, 30);
            LGKM(14); o[11] = __builtin_amdgcn_mfma_f32_16x16x32_bf16(pa[1], (bf16x8){F7l[0], F7l[1], F7l[2], F7l[3], F7h[0], F7h[1], F7h[2], F7h[3]}, o[11], 0, 0, 0); SBAR(); VRD1(F7, 31);
            LGKM(14); o[12] = __builtin_amdgcn_mfma_f32_16x16x32_bf16(pa[0], (bf16x8){F0l[0], F0l[1], F0l[2], F0l[3], F0h[0], F0h[1], F0h[2], F0h[3]}, o[12], 0, 0, 0);
            LGKM(12); o[12] = __builtin_amdgcn_mfma_f32_16x16x32_bf16(pa[1], (bf16x8){F1l[0], F1l[1], F1l[2], F1l[3], F1h[0], F1h[1], F1h[2], F1h[3]}, o[12], 0, 0, 0);
            LGKM(10); o[13] = __builtin_amdgcn_mfma_f32_16x16x32_bf16(pa[0], (bf16x8){F2l[0], F2l[1], F2l[2], F2l[3], F2h[0], F2h[1], F2h[2], F2h[3]}, o[13], 0, 0, 0);
            LGKM(8); o[13] = __builtin_amdgcn_mfma_f32_16x16x32_bf16(pa[1], (bf16x8){F3l[0], F3l[1], F3l[2], F3l[3], F3h[0], F3h[1], F3h[2], F3h[3]}, o[13], 0, 0, 0);
            LGKM(6); o[14] = __builtin_amdgcn_mfma_f32_16x16x32_bf16(pa[0], (bf16x8){F4l[0], F4l[1], F4l[2], F4l[3], F4h[0], F4h[1], F4h[2], F4h[3]}, o[14], 0, 0, 0);
            LGKM(4); o[14] = __builtin_amdgcn_mfma_f32_16x16x32_bf16(pa[1], (bf16x8){F5l[0], F5l[1], F5l[2], F5l[3], F5h[0], F5h[1], F5h[2], F5h[3]}, o[14], 0, 0, 0);
            LGKM(2); o[15] = __builtin_amdgcn_mfma_f32_16x16x32_bf16(pa[0], (bf16x8){F6l[0], F6l[1], F6l[2], F6l[3], F6h[0], F6h[1], F6h[2], F6h[3]}, o[15], 0, 0, 0);
            LGKM(0); o[15] = __builtin_amdgcn_mfma_f32_16x16x32_bf16(pa[1], (bf16x8){F7l[0], F7l[1], F7l[2], F7l[3], F7h[0], F7h[1], F7h[2], F7h[3]}, o[15], 0, 0, 0);
#undef VRD1
            if (__all(C <= -104.f)) done = true;
        }
        if (nxt_f32) load_tile_f32(lds, b ^ 1, it.kf + (size_t)(j - 1) * 64 * 1024, it.vf + (size_t)(j - 1) * 64 * 1024, tid);
        if (lane == 0) flags[b * 8 + wid] = done ? 1u : 0u;
        asm volatile("s_waitcnt vmcnt(0) lgkmcnt(0)" ::: "memory"); WGBAR();
        if (j == 0) break;
        const unsigned f = (lane < 8) ? flags[b * 8 + lane] : 1u;
        if (!__any(f == 0u)) break;
    }
    asm volatile("s_waitcnt vmcnt(0) lgkmcnt(0)" ::: "memory"); WGBAR();
    if (active) {
        const int rsel = lane >> 5, c0 = (lane & 31) * 8;
        const bf16_t* gp = it.q + 3072 + (size_t)(wq * 32 + dh * 16 + rsel) * NIN + c0;
        u32x4 gv[8];
#pragma unroll
        for (int i = 0; i < 8; ++i) gv[i] = *(const u32x4*)(gp + (size_t)(2 * i) * NIN);
        LAS unsigned char* wb = lds + wid * 16384;
#pragma unroll
        for (int e = 0; e < 4; ++e) { const int ae = q4 * 4096 + q4 * 64 + e * 1024 + ((j16 ^ (e << 2)) << 2);
#pragma unroll
            for (int cb = 0; cb < 16; ++cb) *(LAS float*)(wb + (ae ^ (cb << 6))) = o[cb][e]; }
        const int l0 = rsel * 1024 + (((lane & 31) * 32) ^ (rsel << 4));
        bf16_t* op = it.o + (size_t)(wq * 32 + dh * 16 + rsel) * D + c0;
#pragma unroll
        for (int i = 0; i < 8; ++i) {
            const int ad = 2 * i * 1024 + (l0 ^ (((i >> 1) << 6) ^ ((i & 1) << 5)));
            const f32x4 oa = *(const LAS f32x4*)(wb + ad), ob = *(const LAS f32x4*)(wb + (ad ^ 16));
            u32x4 w;
#pragma unroll
            for (int k = 0; k < 4; ++k) { const float g0 = bf_lo(gv[i][k]), g1 = bf_hi(gv[i][k]);
                const float x0 = (k < 2) ? oa[2 * k] : ob[2 * k - 4], x1 = (k < 2) ? oa[2 * k + 1] : ob[2 * k - 3];
                w[k] = cvtpk(x0 * g0 / (1.0f + __expf(-g0)), x1 * g1 / (1.0f + __expf(-g1))); }
            *(u32x4*)(op + (size_t)(2 * i) * D) = w;
        }
    }
    WGBAR();
}
}

struct DSched { unsigned short it[32][8]; unsigned char n[32]; };
__device__ const DSched g_dsched = { {{127, 320, 42, 284, 0, 0, 0, 0}, {126, 321, 37, 259, 128, 0, 0, 0}, {125, 322, 49, 278, 0, 0, 0, 0}, {124, 323, 43, 256, 129, 0, 0, 0}, {123, 324, 36, 287, 0, 0, 0, 0}, {122, 325, 39, 258, 130, 0, 0, 0}, {121, 326, 32, 266, 131, 0, 0, 0}, {120, 327, 38, 286, 0, 0, 0, 0}, {119, 328, 55, 272, 0, 0, 0, 0}, {118, 329, 60, 267, 0, 0, 0, 0}, {117, 330, 51, 276, 0, 0, 0, 0}, {116, 331, 53, 274, 0, 0, 0, 0}, {115, 332, 61, 264, 0, 0, 0, 0}, {114, 333, 47, 280, 0, 0, 0, 0}, {113, 334, 33, 265, 132, 0, 0, 0}, {112, 335, 35, 261, 133, 0, 0, 0}, {111, 336, 63, 260, 0, 0, 0, 0}, {110, 337, 41, 257, 134, 0, 0, 0}, {109, 338, 45, 282, 0, 0, 0, 0}, {108, 339, 50, 277, 0, 0, 0, 0}, {107, 340, 54, 273, 0, 0, 0, 0}, {106, 341, 40, 285, 0, 0, 0, 0}, {105, 342, 58, 269, 0, 0, 0, 0}, {104, 343, 59, 268, 0, 0, 0, 0}, {103, 344, 62, 262, 0, 0, 0, 0}, {102, 345, 57, 270, 0, 0, 0, 0}, {101, 346, 46, 281, 0, 0, 0, 0}, {100, 347, 56, 271, 0, 0, 0, 0}, {99, 348, 52, 275, 0, 0, 0, 0}, {98, 349, 44, 283, 0, 0, 0, 0}, {97, 350, 34, 263, 135, 0, 0, 0}, {96, 351, 48, 279, 0, 0, 0, 0}}, {4, 5, 4, 5, 4, 5, 5, 4, 4, 4, 4, 4, 4, 4, 5, 5, 4, 5, 4, 4, 4, 4, 4, 4, 4, 4, 4, 4, 4, 4, 5, 4} };

#define CAS __attribute__((address_space(4)))
#define KARGS() const CAS unsigned char* kp_ = (const CAS unsigned char*)__builtin_amdgcn_kernarg_segment_ptr(); asm volatile("" : "+s"(kp_))
#define KIN(i) as_global(*(const float* const CAS*)(kp_ + 8 * (i)))
#define KOUT() as_global(*(float* const CAS*)(kp_ + 80))
#define KWS() as_global(*(unsigned char* const CAS*)(kp_ + 88))
__global__ void __launch_bounds__(NTHR, 2) fwd(const float* in0, const float* in1, const float* in2, const float* in3, const float* in4, const float* in5, const float* in6,
                                               const float* in7, const float* in8, const float* in9, float* out_, unsigned char* ws_, int ph_lo, int ph_hi) {
    extern __shared__ __attribute__((aligned(16))) unsigned char lds_raw[];
    LAS unsigned char* lds = (LAS unsigned char*)lds_raw;
    const int G = gridDim.x, bx = blockIdx.x;
    volatile LAS unsigned* misc = (volatile LAS unsigned*)(lds + LDS_MISC);
    if (threadIdx.x < 64) misc[threadIdx.x] = 0u;
    __syncthreads();
    XcdBarrier bar; bar.x = 0; bar.st = misc;
    { KARGS(); bar.bar = (unsigned*)(KWS() + WS_CTL) + CW_BAR; }
    if (!MK_PER_PHASE) bar = xcd_barrier_post(bar.bar, misc);
#define GRID_BAR() do { if (!MK_PER_PHASE) xcd_barrier(bar); } while (0)
    int lo, hi_; { KARGS(); lo = *(const int CAS*)(kp_ + 96); hi_ = *(const int CAS*)(kp_ + 100); }
#define IN(k) (lo <= (k) && (k) < hi_)
#define PHASE_PTRS() \
    KARGS(); unsigned char* ws = KWS(); \
    unsigned* ctl = (unsigned*)(ws + WS_CTL); (void)ctl; \
    bf16_t* H = (bf16_t*)(ws + WS_H); bf16_t* QKVG = (bf16_t*)(ws + WS_QKVG); float* Y = (float*)(ws + WS_Y); (void)H; (void)QKVG; (void)Y; \
    float* out = KOUT(); (void)out;
    if (IN(0)) {
        PHASE_PTRS();
        transpose_weights(KIN(5), KIN(4), (bf16_t*)(ws + WS_WIN), NIN, DEPTH, (LAS float*)lds);
        transpose_weights(KIN(6), nullptr, (bf16_t*)(ws + WS_WOUT), D, DEPTH, (LAS float*)lds);
        rope_table((float*)(ws + WS_COS), (float*)(ws + WS_SIN));
        norm_phase(KIN(0), KIN(1) - (size_t)MP * D, KIN(4), (bf16_t*)(ws + WS_XB), nullptr, nullptr, (float*)(ws + CTL_SSQ), 2);
        GRID_BAR();
    }
    for (int l = 0; l < DEPTH; ++l) {
        const int pb = 1 + 4 * l;
        const bool even = (l & 1) == 0;
        if (IN(pb)) {
            PHASE_PTRS();
            bf16_t* WIN = (bf16_t*)(ws + WS_WIN); float* COS = (float*)(ws + WS_COS);
            pg8::Gemm g{(bf16_t*)(ws + WS_XB), WIN + (size_t)l * NIN * D}; int bxl = bx; asm volatile("" : "+s"(bxl)); pg8::StaticOrder<MTOT, NIN> S; S.init(G, bxl);
            EpiIn E{QKVG, out, COS, (const float*)(ws + CTL_SSQ) + (size_t)l * MTOT, l};
#ifndef NO_GIN
            pg8::gemm_phase<EpiIn, MTOT, NIN, D>(lds, g, S, E, 0);
#endif
            GRID_BAR();
        }
        if (IN(pb + 1)) {
            PHASE_PTRS();
            bf16_t* CK = (bf16_t*)(ws + WS_CK);
            if (even) {
                const int lane = ltid() & 63;
                const float* lf = KIN(7) + (size_t)(l >> 1) * 4 * 128;
                const float s1 = wave_sum(lf[lane] * lf[128 + lane] + lf[64 + lane] * lf[192 + lane]);
                const float s2 = wave_sum(lf[256 + lane] * lf[384 + lane] + lf[320 + lane] * lf[448 + lane]);
                const float lam_init = (l == 0) ? 0.2f : 0.47071301834358406f;
                const float lam = __int_as_float(__builtin_amdgcn_readfirstlane(__float_as_int(__expf(s1) - __expf(s2) + lam_init)));
                const float* subw = KIN(8) + (size_t)(l >> 1) * 256;
                const bool tab = (G == 256);
                const int nitems = __builtin_amdgcn_readfirstlane(tab ? (int)g_dsched.n[bx >> 3] : (1088 - bx + G - 1) / G);
                for (int k = 0; k < nitems; ++k) {
                    int bh, code;
                    int desc = 0;
                    if (tab) { bh = bx & 7; const int e_ = __builtin_amdgcn_readfirstlane((int)g_dsched.it[bx >> 3][k]); code = e_ & 255; desc = e_ >> 8; }
                    else { const int id = bx + k * G; if (id < 1024) { bh = id & 7; code = id >> 3; } else { bh = (id - 1024) >> 3; code = 128 + ((id - 1024) & 7); } }
                    const bool pr = code < 128;
                    const int x = code, s = bh * 8 + (code - 128);
                    const int b = bh >> 2, h = pr ? (bh & 3) : (s & 3), sb = s >> 2;
                    const size_t row0 = pr ? (size_t)b * SEQ + (size_t)x * 128 : (size_t)MP + (size_t)sb * DSEQ;
                    const size_t krow = pr ? (size_t)b * SEQ : row0;
                    const bf16_t* knew = QKVG + krow * NIN + 1024 + h * 256;
                    const size_t coff = ((size_t)(l * DBATCH + sb) * PAST) * D + h * 256;
                    att::DItem it;
                    it.q = QKVG + row0 * NIN + h * 256;
                    it.kv.k1 = (const char*)knew; it.kv.vd1 = 2048u; it.kv.stride1 = NIN * 2;
                    it.kv.k0 = pr ? (const char*)knew : (const char*)(CK + coff); it.kv.vd0 = pr ? 2048u : (unsigned)(WS_CV - WS_CK);
                    it.kv.stride0 = pr ? NIN * 2 : D * 2; it.kv.nsplit = pr ? (1 << 30) : PAST / 64;
                    it.nt_lo = pr ? 2 * x + 1 : PAST / 64 + 1; it.nt_hi = pr ? 2 * x + 2 : 0;
                    it.o = H + row0 * D + h * 256;
                    it.kf = pr ? nullptr : KIN(2) + coff; it.vf = pr ? nullptr : KIN(3) + coff; it.desc = pr ? desc : 0;
#ifndef NO_DIFF
                    att::diff_item(it, lds, lam, l >> 1, subw);
#endif
                }
            } else {
                for (int k = 0;; ++k) {
                    int id;
                    if (G == 256) {
                        const int v = bx >> 3;
                        if (k == 0) id = v < 8 ? 1024 + bx : ((v - 8) << 3) + (bx & 7);
                        else if (k < 4) id = ((24 + 32 * (k - 1) + v) << 3) + (bx & 7);
                        else { if (k > 4 || v < 8 || v >= 16) break; id = ((112 + v) << 3) + (bx & 7); }
                    } else { id = bx + k * G; if (id >= 1088) break; }
                    const bool pr = id < 1024;
                    const int bh = id & 7, x = id >> 3, s = id - 1024;
                    const int b = bh >> 2, h = pr ? (bh & 3) : (s & 3), sb = s >> 2;
                    const size_t row0 = pr ? (size_t)b * SEQ + (size_t)x * 128 : (size_t)MP + (size_t)sb * DSEQ;
                    const size_t krow = pr ? (size_t)b * SEQ : row0;
                    const bf16_t* knew = QKVG + krow * NIN + 1024 + h * 256;
                    const size_t coff = ((size_t)(l * DBATCH + sb) * PAST) * D + h * 256;
                    att::SItem it;
                    it.q = QKVG + row0 * NIN + h * 256;
                    it.kv.k1 = (const char*)knew; it.kv.vd1 = 2048u; it.kv.stride1 = NIN * 2;
                    it.kv.k0 = pr ? (const char*)knew : (const char*)(CK + coff); it.kv.vd0 = pr ? 2048u : (unsigned)(WS_CV - WS_CK);
                    it.kv.stride0 = pr ? NIN * 2 : D * 2; it.kv.nsplit = pr ? (1 << 30) : PAST / 64;
                    it.P0 = pr ? x * 128 : PAST; it.nrows = pr ? 128 : DSEQ; it.jstart = pr ? 2 * x + 1 : PAST / 64;
                    it.kf = pr ? nullptr : KIN(2) + coff; it.vf = pr ? nullptr : KIN(3) + coff;
                    it.o = H + row0 * D + h * 256;
#ifndef NO_SB
                    att::sb_item(it, lds);
#endif
                }
            }
            GRID_BAR();
        }
        if (IN(pb + 2)) {
            PHASE_PTRS();
            bf16_t* WOUT = (bf16_t*)(ws + WS_WOUT);
            pg8::Gemm g{H, WOUT + (size_t)l * D * D}; int bxl = bx; asm volatile("" : "+s"(bxl)); pg8::StaticOrder<MTOT, D> S; S.init(G, bxl);
            const bool lastl = l == DEPTH - 1;
            EpiOut E{l == 0 ? KIN(0) : nullptr, l == 0 ? KIN(1) - (size_t)MP * D : nullptr, (bf16_t*)(ws + WS_XB), lastl ? nullptr : (float*)(ws + CTL_SSQ) + (size_t)(l + 1) * MTOT};
#ifndef NO_GOUT
            pg8::gemm_phase<EpiOut, MTOT, D, D>(lds, g, S, E, 0);
#endif
            GRID_BAR();
        }
        if (IN(pb + 3)) {
            PHASE_PTRS();
            if (l == DEPTH - 1) final_norm((const bf16_t*)(ws + WS_XB), KIN(9), out + OY_P, out + OY_S - (size_t)MP * D);
        }
    }
#undef IN
#undef GRID_BAR
}

extern "C" void kernel_launch(void* const* d_in, const int* in_sizes, int n_in, void* d_out, int out_size, void* d_ws, size_t ws_size, hipStream_t stream) {
    static int grid = 0;
    if (grid == 0) {
        if (n_in != 10 || (size_t)out_size != O_END || ws_size < WS_END) { fprintf(stderr, "kernel_launch: unexpected shapes (n_in %d out %d ws %zu, want 10 / %zu / >= %zu)\n", n_in, out_size, ws_size, (size_t)O_END, (size_t)WS_END); grid = -1; return; }
        int dev = 0, cus = 0, per_cu = 0;
        if (hipGetDevice(&dev) != hipSuccess || hipDeviceGetAttribute(&cus, hipDeviceAttributeMultiprocessorCount, dev) != hipSuccess) { grid = -1; return; }
        if (hipFuncSetAttribute((const void*)fwd, hipFuncAttributeMaxDynamicSharedMemorySize, LDS_BYTES) != hipSuccess) { fprintf(stderr, "kernel_launch: hipFuncSetAttribute failed\n"); grid = -1; return; }
        if (hipOccupancyMaxActiveBlocksPerMultiprocessor(&per_cu, (const void*)fwd, NTHR, LDS_BYTES) != hipSuccess || per_cu < 1) { fprintf(stderr, "kernel_launch: occupancy query says %d blocks per CU\n", per_cu); }
        (void)hipGetLastError();
        grid = cus;
    }
    if (grid < 0) return;
    (void)hipMemsetAsync((char*)d_ws + WS_CTL, 0, CTL_BYTES, stream);
    const float* in[10];
    for (int i = 0; i < 10; ++i) in[i] = (const float*)d_in[i];
#if MK_PER_PHASE
    for (int p = 0; p < 17; ++p) hipLaunchKernelGGL(fwd, dim3(grid), dim3(NTHR), LDS_BYTES, stream, in[0], in[1], in[2], in[3], in[4], in[5], in[6], in[7], in[8], in[9], (float*)d_out, (unsigned char*)d_ws, p, p + 1);
#else
    hipLaunchKernelGGL(fwd, dim3(grid), dim3(NTHR), LDS_BYTES, stream, in[0], in[1], in[2], in[3], in[4], in[5], in[6], in[7], in[8], in[9], (float*)d_out, (unsigned char*)d_ws, 0, 17);
#endif
}
```

```cpp
#include <hip/hip_runtime.h>
#include <cstdio>
#include <cstdint>

#ifndef MK_PER_PHASE
#define MK_PER_PHASE 0
#endif

constexpr int D = 1024, NBATCH = 2, SEQ = 16384, DEPTH = 4, DBATCH = 16, DSEQ = 64, PAST = 2048;
constexpr int MP = NBATCH * SEQ, MS = DBATCH * DSEQ, MTOT = MP + MS;
constexpr int NIN = 4 * D;
constexpr float EPS = 1e-6f;
constexpr size_t OY_P = 0, OY_S = OY_P + (size_t)MP * D, OK_P = OY_S + (size_t)MS * D, OV_P = OK_P + (size_t)DEPTH * MP * D,
                 OK_S = OV_P + (size_t)DEPTH * MP * D, OV_S = OK_S + (size_t)DEPTH * MS * D, O_END = OV_S + (size_t)DEPTH * MS * D;
constexpr size_t WS_CTL = 0, CTL_BYTES = 1048576;
constexpr size_t WS_WIN = WS_CTL + CTL_BYTES;
constexpr size_t WS_WOUT = WS_WIN + (size_t)DEPTH * NIN * D * 2;
constexpr size_t WS_COS = WS_WOUT + (size_t)DEPTH * D * D * 2;
constexpr size_t WS_SIN = WS_COS + (size_t)SEQ * 64 * 4;
constexpr size_t WS_H = WS_SIN + (size_t)SEQ * 64 * 4;
constexpr size_t WS_QKVG = WS_H + (size_t)MTOT * D * 2;
constexpr size_t WS_Y = WS_QKVG + (size_t)MTOT * NIN * 2;
constexpr size_t WS_CK = WS_Y + (size_t)MTOT * D * 4;
constexpr size_t WS_CV = WS_CK + (size_t)DEPTH * DBATCH * PAST * D * 2;
constexpr size_t WS_XB = WS_CV + (size_t)DEPTH * DBATCH * PAST * D * 2;
constexpr size_t WS_END = WS_XB + (size_t)MTOT * D * 2;
constexpr size_t CTL_SSQ = 65536;
constexpr int CW_BAR = 0;
constexpr int CW_KM = 4096;
constexpr int CW_TMO = 4096 + 256;

typedef unsigned short bf16_t;
typedef short bf16x8 __attribute__((ext_vector_type(8)));
typedef short s16x4 __attribute__((ext_vector_type(4)));
typedef float f32x16 __attribute__((ext_vector_type(16)));
typedef float f32x4 __attribute__((ext_vector_type(4)));
typedef float f32x2 __attribute__((ext_vector_type(2)));
typedef unsigned u32x4 __attribute__((ext_vector_type(4)));
typedef unsigned u32x2 __attribute__((ext_vector_type(2)));
#define LAS __attribute__((address_space(3)))
#define GAS __attribute__((address_space(1)))
template <class T> __device__ __forceinline__ T* as_global(T* p) { return (T*)(GAS T*)p; }

__device__ __forceinline__ unsigned cvtpk(float lo, float hi) { unsigned r; asm volatile("v_cvt_pk_bf16_f32 %0, %1, %2" : "=v"(r) : "v"(lo), "v"(hi)); return r; }
__device__ __forceinline__ float bf_lo(unsigned w) { return __uint_as_float(w << 16); }
__device__ __forceinline__ float bf_hi(unsigned w) { return __uint_as_float(w & 0xffff0000u); }
__device__ __forceinline__ float bf2f(bf16_t b) { return __uint_as_float(((unsigned)b) << 16); }
template <int M> __device__ __forceinline__ float xor_lane(float v) { return __int_as_float(__builtin_amdgcn_ds_swizzle(__float_as_int(v), (M << 10) | 0x1f)); }
__device__ __forceinline__ float wave_sum(float v) {
    v += xor_lane<1>(v); v += xor_lane<2>(v); v += xor_lane<4>(v); v += xor_lane<8>(v); v += xor_lane<16>(v);
    auto rr = __builtin_amdgcn_permlane32_swap(__float_as_uint(v), __float_as_uint(v), false, false); return __uint_as_float(rr[0]) + __uint_as_float(rr[1]); }
__device__ __forceinline__ float half_sum(float v) { v += xor_lane<1>(v); v += xor_lane<2>(v); v += xor_lane<4>(v); v += xor_lane<8>(v); v += xor_lane<16>(v); return v; }

#define XB_TMO      128
#define XB_XCNT(j)  (256  + 64 * (j))
#define XB_XSUB(j)  (1280 + 64 * (j))
#define XB_XGEN(j)  (2304 + 64 * (j))
#define XB_TOP      3328
#define XB_TOPGEN   3392
#define XCD_BAR_WORDS 3456
#define XB_SPIN_CAP (1u << 22)
__device__ __forceinline__ unsigned xb_ld(unsigned* p)              { return __hip_atomic_load(p, __ATOMIC_RELAXED, __HIP_MEMORY_SCOPE_AGENT); }
__device__ __forceinline__ unsigned xb_add(unsigned* p, unsigned v) { return __hip_atomic_fetch_add(p, v, __ATOMIC_RELAXED, __HIP_MEMORY_SCOPE_AGENT); }
__device__ __forceinline__ unsigned xb_xcc_id() { return (unsigned)__builtin_amdgcn_s_getreg((3 << 11) | 20) & 0xFu; }
#define XB_SPIN(cond, bar) do { unsigned _sp = 0; while (cond) { __builtin_amdgcn_s_sleep(1); \
    if ((++_sp & 255u) == 0u) { if (xb_ld(&(bar)[XB_TMO])) break; if (_sp > XB_SPIN_CAP) { atomicAdd(&(bar)[XB_TMO], 1u); break; } } } } while (0)
struct XcdBarrier { unsigned* bar; unsigned x; volatile LAS unsigned* st; };
__device__ __forceinline__ XcdBarrier xcd_barrier_post(unsigned* bar, volatile LAS unsigned* st) {
    XcdBarrier b; b.bar = bar; b.x = xb_xcc_id(); b.st = st;
    if (threadIdx.x == 0) (void)xb_add(&bar[XB_XCNT(b.x)], 1u);
    return b;
}
__device__ __forceinline__ void xcd_barrier_complete(unsigned* bar, unsigned x, unsigned& nloc, unsigned& nx) {
    const unsigned G = gridDim.x * gridDim.y * gridDim.z;
    unsigned sum, cnt, mine, sp = 0u;
    for (;;) {
        sum = 0u; cnt = 0u; mine = 0u;
#pragma unroll
        for (unsigned j = 0; j < 16; ++j) { const unsigned c = xb_ld(&bar[XB_XCNT(j)]); sum += c; cnt += (c > 0u) ? 1u : 0u; mine = (j == x) ? c : mine; }
        if (sum == G) break;
        __builtin_amdgcn_s_sleep(1);
        if ((++sp & 255u) == 0u) { if (xb_ld(&bar[XB_TMO])) break; if (sp > XB_SPIN_CAP) { atomicAdd(&bar[XB_TMO], 1u); break; } }
    }
    nloc = mine > 0u ? mine : 1u; nx = cnt > 0u ? cnt : 1u;
}
__device__ __forceinline__ void xcd_barrier(const XcdBarrier& b) {
    asm volatile("s_waitcnt vmcnt(0)" ::: "memory");
    __syncthreads();
    if (threadIdx.x == 0) {
        unsigned* bar = b.bar;
        __builtin_amdgcn_s_waitcnt(0);
        unsigned nloc = b.st[0], nx = b.st[1];
        if (nloc == 0u) { xcd_barrier_complete(bar, b.x, nloc, nx); b.st[0] = nloc; b.st[1] = nx; }
        const unsigned old = xb_add(&bar[XB_XSUB(b.x)], 1u);
        const unsigned gen = old / nloc;
        if (old + 1u == (gen + 1u) * nloc) {
            __builtin_amdgcn_fence(__ATOMIC_RELEASE, "agent");
            asm volatile("s_waitcnt vmcnt(0)" ::: "memory");
            const unsigned og = xb_add(&bar[XB_TOP], 1u);
            const unsigned tg = og / nx;
            if (og + 1u == (tg + 1u) * nx) xb_add(&bar[XB_TOPGEN], 1u);
            else XB_SPIN(xb_ld(&bar[XB_TOPGEN]) == tg, bar);
            __builtin_amdgcn_fence(__ATOMIC_ACQUIRE, "agent");
            xb_add(&bar[XB_XGEN(b.x)], 1u);
            asm volatile("s_waitcnt vmcnt(0)" ::: "memory");
        } else {
            XB_SPIN(xb_ld(&bar[XB_XGEN(b.x)]) == gen, bar);
            __builtin_amdgcn_fence(__ATOMIC_ACQUIRE, "agent");
            asm volatile("s_waitcnt vmcnt(0)" ::: "memory");
        }
    }
    __syncthreads();
}

namespace pg8 {
constexpr int BM = 256, BK = 64, HALF = 128, HTB = HALF * BK * 2, STAGE_BYTES = 8 * HTB, NXCD = 8, WGM = 8;
__host__ __device__ __forceinline__ int lds_byte(int r, int c) { const int st = (r >> 4) * 2 + (c >> 5), rr = r & 15, cc = c & 31, ob = rr * 64 + cc * 2; return st * 1024 + (ob ^ (((ob >> 9) & 1) << 5)); }
__host__ __device__ __forceinline__ void stage_rc(int b, int& R, int& C) { const int st = b / 1024, sb = b % 1024, swz = sb ^ (((sb >> 9) & 1) << 5); R = (st >> 1) * 16 + swz / 64; C = (st & 1) * 32 + (swz % 64) / 2; }
__host__ __device__ __forceinline__ int perm32(int rho) { const int n = rho >> 4, i = rho & 15; return 8 * (i >> 2) + 4 * n + (i & 3); }
struct Unit { int pm, pn; };
struct Gemm { const bf16_t* A; const bf16_t* Bt; };
template <int M_, int N_> struct StaticOrder {
    static constexpr int nM = M_ / BM, nN = N_ / BM, nwg = nM * nN;
    int G, c;
    __host__ __device__ void init(int G_, int c_) { G = G_; c = c_; }
    __host__ __device__ bool next(int i, Unit& u) const {
        const long L = (long)i * G + c; if (L >= nwg) return false;
        int wgid = (int)L; { const int q = nwg / NXCD, r = nwg % NXCD, xcd = wgid % NXCD, off = wgid / NXCD; wgid = (xcd < r ? xcd * (q + 1) : r * (q + 1) + (xcd - r) * q) + off; }
        const int nig = WGM * nN, gid = wgid / nig, fm = gid * WGM, gsz = (nM - fm) < WGM ? (nM - fm) : WGM;
        u.pm = fm + ((wgid % nig) % gsz); u.pn = (wgid % nig) / gsz; return true;
    }
};

template <class Epi, int M_, int N_, int K_>
__device__ __forceinline__ void gemm_phase(LAS unsigned char* lds, const Gemm g, const StaticOrder<M_, N_>& S, const Epi& E, int stagger_ticks) {
    int tid = threadIdx.x; asm volatile("" : "+v"(tid));
    const int wid = __builtin_amdgcn_readfirstlane(tid >> 6), lane = tid & 63, wr = wid >> 2, wc = wid & 3, fr = lane & 15, fq = lane >> 4;
    constexpr int K = K_, nt = K / BK;
    unsigned voffA[2], voffB[2];
#pragma unroll
    for (int i = 0; i < 2; ++i) { int R, C; stage_rc(tid * 16 + i * 8192, R, C); const int Rb = Epi::brow(R);
        voffA[i] = (unsigned)(R * K + C) * 2u; voffB[i] = (unsigned)(Rb * K + C) * 2u; }
    constexpr size_t kstep = (size_t)(BK * 2);
    constexpr size_t hstep = (size_t)HALF * K * 2;
    constexpr size_t hstepB = (size_t)Epi::BHROWS * K * 2;
    constexpr size_t tstep = 2 * hstep;
    const unsigned ldsw = (unsigned)wid * 1024u;
    const int aoff = lds_byte(wr * 64 + fr, fq * 8), boff = lds_byte(wc * 32 + fr, fq * 8);
#define PG8_SA(b, h) (((b) * 2 + (h)) * HTB)
#define PG8_SB(b, h) ((4 + (b) * 2 + (h)) * HTB)
#define PG8_STAGE(bufoff, gbase, voff) do { _Pragma("unroll") for (int _i = 0; _i < 2; ++_i) \
        __builtin_amdgcn_global_load_lds((const unsigned*)((const char*)(gbase) + (voff)[_i]), (LAS unsigned*)(lds + (bufoff) + ldsw + _i * 8192), 16, 0, 0); } while (0)
#define PG8_LDA(dst, b, h) do { _Pragma("unroll") for (int m = 0; m < 4; ++m) _Pragma("unroll") for (int k = 0; k < 2; ++k) dst[m][k] = *(const LAS bf16x8*)(lds + PG8_SA(b, h) + aoff + m * 2048 + k * 1024); } while (0)
#define PG8_LDB(dst, b, h) do { _Pragma("unroll") for (int n = 0; n < 2; ++n) _Pragma("unroll") for (int k = 0; k < 2; ++k) dst[n][k] = *(const LAS bf16x8*)(lds + PG8_SB(b, h) + boff + n * 2048 + k * 1024); } while (0)
#define PG8_MMA(ai, bj, At, Bt) do { __builtin_amdgcn_s_setprio(1); _Pragma("unroll") for (int m = 0; m < 4; ++m) _Pragma("unroll") for (int n = 0; n < 2; ++n) _Pragma("unroll") for (int k = 0; k < 2; ++k) \
        acc[ai][bj][m][n] = __builtin_amdgcn_mfma_f32_16x16x32_bf16(Bt[n][k], At[m][k], acc[ai][bj][m][n], 0, 0, 0); __builtin_amdgcn_s_setprio(0); } while (0)
#define PG8_WAIT_V(n) asm volatile("s_waitcnt vmcnt(" #n ")" ::: "memory")
#define PG8_WAIT_L(n) asm volatile("s_waitcnt lgkmcnt(" #n ")" ::: "memory")
#define PG8_BAR __builtin_amdgcn_s_barrier()
#define PG8_SCHED __builtin_amdgcn_sched_barrier(0)
    Unit cur, nxt; int ui = 0;
    if (!S.next(0, cur)) return;
    if (stagger_ticks) {
        const unsigned long long t0 = __builtin_amdgcn_s_memrealtime(); const unsigned long long w = (unsigned long long)((S.c >> 3) & 15) * (unsigned)stagger_ticks;
        while (__builtin_amdgcn_s_memrealtime() - t0 < w) __builtin_amdgcn_s_sleep(8);
    }
    f32x4 acc[2][2][4][2];
#pragma unroll
    for (int a = 0; a < 2; ++a)
#pragma unroll
        for (int b = 0; b < 2; ++b)
#pragma unroll
            for (int m = 0; m < 4; ++m)
#pragma unroll
                for (int n = 0; n < 2; ++n) acc[a][b][m][n] = (f32x4){0.f, 0.f, 0.f, 0.f};
    bf16x8 At[4][2], B0[2][2], B1[2][2];
    const char* cA = (const char*)g.A + (size_t)cur.pm * tstep; const char* cB = (const char*)g.Bt + (size_t)cur.pn * tstep;
    PG8_STAGE(PG8_SB(0, 0), cB, voffB); PG8_STAGE(PG8_SA(0, 0), cA, voffA); PG8_STAGE(PG8_SB(0, 1), cB + hstepB, voffB); PG8_STAGE(PG8_SA(0, 1), cA + hstep, voffA);
    if (wr == 1) PG8_BAR;
    PG8_WAIT_V(4); PG8_BAR;
    PG8_STAGE(PG8_SB(1, 0), cB + kstep, voffB); PG8_STAGE(PG8_SA(1, 0), cA + kstep, voffA); PG8_STAGE(PG8_SB(1, 1), cB + hstepB + kstep, voffB);
    PG8_WAIT_V(6); PG8_BAR;
    for (;;) {
        const bool has_next = S.next(ui + 1, nxt);
        const char* nA = has_next ? (const char*)g.A + (size_t)nxt.pm * tstep : cA; const char* nB = has_next ? (const char*)g.Bt + (size_t)nxt.pn * tstep : cB;
        for (int t = 0; t < nt; t += 2) {
            const bool last = (t == nt - 2);
            const char* a1 = cA + (size_t)(t + 1) * kstep;
            const char* a2 = last ? nA : cA + (size_t)(t + 2) * kstep; const char* b2 = last ? nB : cB + (size_t)(t + 2) * kstep;
            const char* a3 = a2 + kstep; const char* b3 = b2 + kstep;
            PG8_LDB(B0, 0, 0); PG8_SCHED; PG8_LDA(At, 0, 0); PG8_STAGE(PG8_SA(1, 1), a1 + hstep, voffA);
            PG8_WAIT_L(8); PG8_BAR; PG8_WAIT_L(0); PG8_MMA(0, 0, At, B0); PG8_BAR; PG8_SCHED;
            PG8_LDB(B1, 0, 1); PG8_STAGE(PG8_SB(0, 0), b2, voffB);
            PG8_BAR; PG8_WAIT_L(0); PG8_MMA(0, 1, At, B1); PG8_BAR;
            PG8_LDA(At, 0, 1); PG8_STAGE(PG8_SA(0, 0), a2, voffA);
            PG8_BAR; PG8_WAIT_L(0); PG8_MMA(1, 0, At, B0); PG8_BAR; PG8_SCHED;
            PG8_STAGE(PG8_SB(0, 1), b2 + hstepB, voffB);
            PG8_WAIT_V(6); PG8_BAR; PG8_MMA(1, 1, At, B1); PG8_BAR;
            PG8_LDB(B0, 1, 0); PG8_SCHED; PG8_LDA(At, 1, 0); PG8_STAGE(PG8_SA(0, 1), a2 + hstep, voffA);
            PG8_WAIT_L(8); PG8_BAR; PG8_WAIT_L(0); PG8_MMA(0, 0, At, B0); PG8_BAR; PG8_SCHED;
            PG8_LDB(B1, 1, 1); PG8_STAGE(PG8_SB(1, 0), b3, voffB);
            PG8_BAR; PG8_WAIT_L(0); PG8_MMA(0, 1, At, B1); PG8_BAR;
            PG8_LDA(At, 1, 1); PG8_STAGE(PG8_SA(1, 0), a3, voffA);
            PG8_BAR; PG8_WAIT_L(0); PG8_MMA(1, 0, At, B0); PG8_BAR; PG8_SCHED;
            PG8_STAGE(PG8_SB(1, 1), b3 + hstepB, voffB);
            PG8_WAIT_V(6); PG8_BAR; PG8_MMA(1, 1, At, B1); PG8_BAR;
        }
        E(acc, cur, wr, wc, fr, fq);
        if (!has_next) break;
#pragma unroll
        for (int a = 0; a < 2; ++a)
#pragma unroll
            for (int b = 0; b < 2; ++b)
#pragma unroll
                for (int m = 0; m < 4; ++m)
#pragma unroll
                    for (int n = 0; n < 2; ++n) acc[a][b][m][n] = (f32x4){0.f, 0.f, 0.f, 0.f};
        cur = nxt; cA = nA; cB = nB; ++ui;
    }
    PG8_WAIT_V(0);
    if (wr == 0) PG8_BAR;
    PG8_BAR;
#undef PG8_SA
#undef PG8_SB
#undef PG8_STAGE
#undef PG8_LDA
#undef PG8_LDB
#undef PG8_MMA
#undef PG8_WAIT_V
#undef PG8_WAIT_L
#undef PG8_BAR
#undef PG8_SCHED
}
}

struct EpiIn {
    static constexpr int BHROWS = 64;
    __host__ __device__ static __forceinline__ int brow(int R) { const int wc = R >> 5; return 128 * (wc >> 1) + 32 * (wc & 1) + pg8::perm32(R & 31); }
    bf16_t* qkvg; float* out; const float* cosT; const float* ssq; int l;
    __device__ __forceinline__ void operator()(const f32x4 (&acc)[2][2][4][2], const pg8::Unit& u, int wr, int wc, int fr, int fq) const {
        float* ob = out; asm volatile("" : "+s"(ob)); ob = as_global(ob);
        const int rope = (l & 1) ^ 1;
        float* outk_p = ob + OK_P + (size_t)l * MP * D; float* outv_p = ob + OV_P + (size_t)l * MP * D;
        float* outk_s = ob + OK_S + (size_t)l * MS * D; float* outv_s = ob + OV_S + (size_t)l * MS * D;
        const float* sinT = cosT + (size_t)SEQ * 64;
        const int sec = u.pn >> 2, ct = (u.pn & 3) * 256 + 128 * (wc >> 1) + 32 * (wc & 1) + 8 * fq;
        const int row0 = u.pm * 256 + wr * 64 + fr;
        const bool prompt = u.pm < (MP / 256);
        const bool dof = (sec == 1) || (sec == 2);
        float* fo = (sec == 1) ? (prompt ? outk_p : outk_s - (size_t)MP * D) : (prompt ? outv_p : outv_s - (size_t)MP * D);
        const bool dorope = rope && sec < 2;
        const float qs = (!rope && sec == 0) ? 0.0625f : 1.0f;
        const int dcol = 32 * (wc & 1) + 8 * fq;
        float rsv[8];
#pragma unroll
        for (int i = 0; i < 8; ++i) rsv[i] = __hip_atomic_load(ssq + row0 + (i >> 2) * 128 + (i & 3) * 16, __ATOMIC_RELAXED, __HIP_MEMORY_SCOPE_AGENT);
        f32x4 cA[2], sA[2], cB[2], sB[2];
#define RPOS(i_) (prompt ? ((row0 + ((i_) >> 2) * 128 + ((i_) & 3) * 16) & (SEQ - 1)) : PAST + ((row0 + ((i_) >> 2) * 128 + ((i_) & 3) * 16 - MP) & (DSEQ - 1)))
        if (dorope) {
#pragma unroll
            for (int n = 0; n < 2; ++n) { cA[n] = *(const f32x4*)(cosT + (size_t)RPOS(0) * 64 + dcol + 4 * n); sA[n] = *(const f32x4*)(sinT + (size_t)RPOS(0) * 64 + dcol + 4 * n);
                                          cB[n] = *(const f32x4*)(cosT + (size_t)RPOS(1) * 64 + dcol + 4 * n); sB[n] = *(const f32x4*)(sinT + (size_t)RPOS(1) * 64 + dcol + 4 * n); } }
#pragma unroll
        for (int ai = 0; ai < 2; ++ai)
#pragma unroll
            for (int m = 0; m < 4; ++m) {
                const int row = row0 + ai * 128 + m * 16;
                const float rs = qs / sqrtf(rsv[ai * 4 + m] * (1.0f / D) + EPS);
                f32x4 v[2][2];
#pragma unroll
                for (int bj = 0; bj < 2; ++bj)
#pragma unroll
                    for (int n = 0; n < 2; ++n) v[bj][n] = acc[ai][bj][m][n] * rs;
                if (dorope) {
                    f32x4 cC[2] = {cA[0], cA[1]}, sC[2] = {sA[0], sA[1]};
#pragma unroll
                    for (int n = 0; n < 2; ++n) { cA[n] = cB[n]; sA[n] = sB[n]; }
                    if (ai * 4 + m < 6) {
#pragma unroll
                        for (int n = 0; n < 2; ++n) { cB[n] = *(const f32x4*)(cosT + (size_t)RPOS(ai * 4 + m + 2) * 64 + dcol + 4 * n); sB[n] = *(const f32x4*)(sinT + (size_t)RPOS(ai * 4 + m + 2) * 64 + dcol + 4 * n); } }
#pragma unroll
                    for (int n = 0; n < 2; ++n) {
                        const f32x4 x1 = v[0][n], x2 = v[1][n];
                        v[0][n] = x1 * cC[n] - x2 * sC[n]; v[1][n] = x2 * cC[n] + x1 * sC[n];
                    }
                }
                bf16_t* qp = qkvg + (size_t)row * NIN + sec * 1024 + ct;
#pragma unroll
                for (int bj = 0; bj < 2; ++bj) {
                    u32x4 w; w.x = cvtpk(v[bj][0][0], v[bj][0][1]); w.y = cvtpk(v[bj][0][2], v[bj][0][3]); w.z = cvtpk(v[bj][1][0], v[bj][1][1]); w.w = cvtpk(v[bj][1][2], v[bj][1][3]);
                    *(u32x4*)(qp + bj * 64) = w;
                }
                if (dof) {
                    GAS float* fp = (GAS float*)(fo + (size_t)row * D + ct);
#pragma unroll
                    for (int bj = 0; bj < 2; ++bj) { __builtin_nontemporal_store(v[bj][0], (GAS f32x4*)(fp + bj * 64)); __builtin_nontemporal_store(v[bj][1], (GAS f32x4*)(fp + bj * 64 + 4)); }
                }
            }
    }
};
struct EpiOut {
    static constexpr int BHROWS = 128;
    __host__ __device__ static __forceinline__ int brow(int R) { return (R & ~31) + pg8::perm32(R & 31); }
    const float* x0p; const float* x0s; bf16_t* xb; float* ssq;
    __device__ __forceinline__ void operator()(const f32x4 (&acc)[2][2][4][2], const pg8::Unit& u, int wr, int wc, int fr, int fq) const {
        const int row0 = u.pm * 256 + wr * 64 + fr, col0 = u.pn * 256 + wc * 32 + 8 * fq;
#define YROW(i_) ((size_t)(row0 + ((i_) >> 2) * 128 + ((i_) & 3) * 16) * D + col0)
        if (x0p) {
            const float* yi = (u.pm < (MP / 256)) ? x0p : x0s;
            f32x4 yA[2][2], yB[2][2];
#pragma unroll
            for (int bj = 0; bj < 2; ++bj)
#pragma unroll
                for (int n = 0; n < 2; ++n) { yA[bj][n] = *(const f32x4*)(yi + YROW(0) + bj * 128 + n * 4); yB[bj][n] = *(const f32x4*)(yi + YROW(1) + bj * 128 + n * 4); }
#pragma unroll
            for (int g8 = 0; g8 < 8; ++g8) { const int ai = g8 >> 2, m = g8 & 3; const int row = row0 + ai * 128 + m * 16; const size_t ro = (size_t)row * D + col0;
                f32x4 yC[2][2];
#pragma unroll
                for (int bj = 0; bj < 2; ++bj)
#pragma unroll
                    for (int n = 0; n < 2; ++n) { yC[bj][n] = yA[bj][n]; yA[bj][n] = yB[bj][n]; }
                if (g8 < 6) {
#pragma unroll
                    for (int bj = 0; bj < 2; ++bj)
#pragma unroll
                        for (int n = 0; n < 2; ++n) yB[bj][n] = *(const f32x4*)(yi + YROW(g8 + 2) + bj * 128 + n * 4); }
                float s = 0.f;
#pragma unroll
                for (int bj = 0; bj < 2; ++bj) { const f32x4 y0 = yC[bj][0] + acc[ai][bj][m][0], y1 = yC[bj][1] + acc[ai][bj][m][1];
                    const u32x4 w = {cvtpk(y0[0], y0[1]), cvtpk(y0[2], y0[3]), cvtpk(y1[0], y1[1]), cvtpk(y1[2], y1[3])};
                    *(u32x4*)(xb + ro + bj * 128) = w;
#pragma unroll
                    for (int e = 0; e < 4; ++e) { const float a0 = bf_lo(w[e]), a1 = bf_hi(w[e]); s += a0 * a0 + a1 * a1; } }
                s += xor_lane<16>(s); { auto rr = __builtin_amdgcn_permlane32_swap(__float_as_uint(s), __float_as_uint(s), false, false); s = __uint_as_float(rr[0]) + __uint_as_float(rr[1]); }
                if (fq == 0) __hip_atomic_fetch_add(ssq + row, s, __ATOMIC_RELAXED, __HIP_MEMORY_SCOPE_AGENT); }
        } else {
            u32x4 yA[2], yB[2];
#pragma unroll
            for (int bj = 0; bj < 2; ++bj) { yA[bj] = *(const u32x4*)(xb + YROW(0) + bj * 128); yB[bj] = *(const u32x4*)(xb + YROW(1) + bj * 128); }
#pragma unroll
            for (int g8 = 0; g8 < 8; ++g8) { const int ai = g8 >> 2, m = g8 & 3; const int row = row0 + ai * 128 + m * 16; const size_t ro = (size_t)row * D + col0;
                u32x4 yC[2];
#pragma unroll
                for (int bj = 0; bj < 2; ++bj) { yC[bj] = yA[bj]; yA[bj] = yB[bj]; }
                if (g8 < 6) {
#pragma unroll
                    for (int bj = 0; bj < 2; ++bj) yB[bj] = *(const u32x4*)(xb + YROW(g8 + 2) + bj * 128); }
                float s = 0.f;
#pragma unroll
                for (int bj = 0; bj < 2; ++bj) { const f32x4 a0v = acc[ai][bj][m][0], a1v = acc[ai][bj][m][1]; const u32x4 yo = yC[bj];
                    const u32x4 w = {cvtpk(bf_lo(yo[0]) + a0v[0], bf_hi(yo[0]) + a0v[1]), cvtpk(bf_lo(yo[1]) + a0v[2], bf_hi(yo[1]) + a0v[3]),
                                     cvtpk(bf_lo(yo[2]) + a1v[0], bf_hi(yo[2]) + a1v[1]), cvtpk(bf_lo(yo[3]) + a1v[2], bf_hi(yo[3]) + a1v[3])};
                    *(u32x4*)(xb + ro + bj * 128) = w;
#pragma unroll
                    for (int e = 0; e < 4; ++e) { const float a0 = bf_lo(w[e]), a1 = bf_hi(w[e]); s += a0 * a0 + a1 * a1; } }
                if (ssq) { s += xor_lane<16>(s); { auto rr = __builtin_amdgcn_permlane32_swap(__float_as_uint(s), __float_as_uint(s), false, false); s = __uint_as_float(rr[0]) + __uint_as_float(rr[1]); }
                    if (fq == 0) __hip_atomic_fetch_add(ssq + row, s, __ATOMIC_RELAXED, __HIP_MEMORY_SCOPE_AGENT); } }
        }
#undef YROW
    }
};

constexpr int NW = 8, NTHR = 512;
constexpr int LDS_MAIN = 131072, LDS_SCR = LDS_MAIN, LDS_SCR_BYTES = 8 * 512, LDS_MISC = LDS_SCR + LDS_SCR_BYTES, LDS_BYTES = LDS_MISC + 256;

__device__ __forceinline__ int ltid() { int t = threadIdx.x; asm volatile("" : "+v"(t)); return t; }
__device__ __forceinline__ void norm_phase(const float* xp, const float* xs  , const float* g, bf16_t* hb, float* op, float* os  , float* ssq, int mode) {
    const int tid = ltid(), lane = tid & 63, wid = tid >> 6;
    f32x4 gw[4];
#pragma unroll
    for (int i = 0; i < 2; ++i) { gw[2 * i] = *(const f32x4*)(g + i * 512 + lane * 8); gw[2 * i + 1] = *(const f32x4*)(g + i * 512 + lane * 8 + 4); }
    const int rstep = gridDim.x * NW;
    f32x4 vn[4];
    { const int row = blockIdx.x * NW + wid; if (row < MTOT) { const float* x = (row < MP ? xp : xs) + (size_t)row * D;
#pragma unroll
        for (int i = 0; i < 2; ++i) { vn[2 * i] = __builtin_nontemporal_load((const f32x4*)(x + i * 512 + lane * 8)); vn[2 * i + 1] = __builtin_nontemporal_load((const f32x4*)(x + i * 512 + lane * 8 + 4)); } } }
    for (int row = blockIdx.x * NW + wid; row < MTOT; row += rstep) {
        f32x4 v[4];
#pragma unroll
        for (int i = 0; i < 4; ++i) v[i] = vn[i];
        if (row + rstep < MTOT) { const float* x = (row + rstep < MP ? xp : xs) + (size_t)(row + rstep) * D;
#pragma unroll
            for (int i = 0; i < 2; ++i) { vn[2 * i] = __builtin_nontemporal_load((const f32x4*)(x + i * 512 + lane * 8)); vn[2 * i + 1] = __builtin_nontemporal_load((const f32x4*)(x + i * 512 + lane * 8 + 4)); } }
        float s = 0.f;
#pragma unroll
        for (int i = 0; i < 4; ++i) s += v[i][0] * v[i][0] + v[i][1] * v[i][1] + v[i][2] * v[i][2] + v[i][3] * v[i][3];
        s = wave_sum(s);
        if (mode == 2) { if (lane == 0) ssq[row] = s; }
        else { const float r = 1.0f / sqrtf(s * (1.0f / D) + EPS);
#pragma unroll
            for (int i = 0; i < 4; ++i) v[i] = v[i] * r * gw[i]; }
        if (mode != 1) {
#pragma unroll
            for (int i = 0; i < 2; ++i) { u32x4 w; w.x = cvtpk(v[2 * i][0], v[2 * i][1]); w.y = cvtpk(v[2 * i][2], v[2 * i][3]); w.z = cvtpk(v[2 * i + 1][0], v[2 * i + 1][1]); w.w = cvtpk(v[2 * i + 1][2], v[2 * i + 1][3]);
                *(u32x4*)(hb + (size_t)row * D + i * 512 + lane * 8) = w; }
        } else {
            float* o = (row < MP ? op : os) + (size_t)row * D;
#pragma unroll
            for (int i = 0; i < 2; ++i) { __builtin_nontemporal_store(v[2 * i], (f32x4*)(o + i * 512 + lane * 8)); __builtin_nontemporal_store(v[2 * i + 1], (f32x4*)(o + i * 512 + lane * 8 + 4)); }
        }
    }
}
__device__ __forceinline__ void final_norm(const bf16_t* xb, const float* g, float* op, float* os  ) {
    const int tid = ltid(), lane = tid & 63, wid = tid >> 6;
    f32x4 gw[4];
#pragma unroll
    for (int i = 0; i < 2; ++i) { gw[2 * i] = *(const f32x4*)(g + i * 512 + lane * 8); gw[2 * i + 1] = *(const f32x4*)(g + i * 512 + lane * 8 + 4); }
    const int rstep = gridDim.x * NW;
    u32x4 vn[2];
    { const int row = blockIdx.x * NW + wid; if (row < MTOT) {
#pragma unroll
        for (int i = 0; i < 2; ++i) vn[i] = *(const u32x4*)(xb + (size_t)row * D + i * 512 + lane * 8); } }
    for (int row = blockIdx.x * NW + wid; row < MTOT; row += rstep) {
        f32x4 v[4];
#pragma unroll
        for (int i = 0; i < 2; ++i) { v[2 * i] = (f32x4){bf_lo(vn[i][0]), bf_hi(vn[i][0]), bf_lo(vn[i][1]), bf_hi(vn[i][1])}; v[2 * i + 1] = (f32x4){bf_lo(vn[i][2]), bf_hi(vn[i][2]), bf_lo(vn[i][3]), bf_hi(vn[i][3])}; }
        if (row + rstep < MTOT) {
#pragma unroll
            for (int i = 0; i < 2; ++i) vn[i] = *(const u32x4*)(xb + (size_t)(row + rstep) * D + i * 512 + lane * 8); }
        float s = 0.f;
#pragma unroll
        for (int i = 0; i < 4; ++i) s += v[i][0] * v[i][0] + v[i][1] * v[i][1] + v[i][2] * v[i][2] + v[i][3] * v[i][3];
        s = wave_sum(s);
        const float r = 1.0f / sqrtf(s * (1.0f / D) + EPS);
        float* o = (row < MP ? op : os) + (size_t)row * D;
#pragma unroll
        for (int i = 0; i < 2; ++i) { __builtin_nontemporal_store(v[2 * i] * r * gw[2 * i], (f32x4*)(o + i * 512 + lane * 8)); __builtin_nontemporal_store(v[2 * i + 1] * r * gw[2 * i + 1], (f32x4*)(o + i * 512 + lane * 8 + 4)); }
    }
}
__device__ __forceinline__ void transpose_weights(const float* W, const float* kscale  , bf16_t* Wt, int N, int nmat, LAS float* sm) {
    const int tid = ltid();
    const int tilesN = N / 64, tilesK = D / 128, per = tilesN * tilesK, total = per * nmat;
    for (int t = blockIdx.x; t < total; t += gridDim.x) {
        const int mat = t / per, tt = t % per, tk = tt / tilesN, tn = tt % tilesN;
        const float* src = W + (size_t)mat * D * N + (size_t)(tk * 128) * N + tn * 64;
        __syncthreads();
#pragma unroll
        for (int p = 0; p < 4; ++p) { const int r = p * 32 + (tid >> 4), c = (tid & 15) * 4; *(LAS f32x4*)(sm + r * 68 + c) = *(const f32x4*)(src + (size_t)r * N + c); }
        __syncthreads();
        const int n = tid & 63, kc = tid >> 6;
        unsigned w[8];
#pragma unroll
        for (int i = 0; i < 8; ++i) { const int k0 = kc * 16 + 2 * i; const float s0 = kscale ? kscale[mat * D + tk * 128 + k0] : 1.f, s1 = kscale ? kscale[mat * D + tk * 128 + k0 + 1] : 1.f;
            w[i] = cvtpk(sm[k0 * 68 + n] * s0, sm[(k0 + 1) * 68 + n] * s1); }
        bf16_t* dst = Wt + (size_t)mat * N * D + (size_t)(tn * 64 + n) * D + tk * 128 + kc * 16;
        *(u32x4*)dst = (u32x4){w[0], w[1], w[2], w[3]}; *(u32x4*)(dst + 8) = (u32x4){w[4], w[5], w[6], w[7]};
    }
    __syncthreads();
}
__device__ __forceinline__ void convert_bf16(const float* src, bf16_t* dst, size_t n) {
    const size_t stride = (size_t)gridDim.x * NTHR * 8 * 4;
    const int tid = ltid();
    for (size_t i = ((size_t)blockIdx.x * 4 * NTHR + tid) * 8; i < n; i += stride) {
        f32x4 a[4], b[4];
#pragma unroll
        for (int u = 0; u < 4; ++u) { a[u] = __builtin_nontemporal_load((const f32x4*)(src + i + (size_t)u * NTHR * 8)); b[u] = __builtin_nontemporal_load((const f32x4*)(src + i + (size_t)u * NTHR * 8 + 4)); }
#pragma unroll
        for (int u = 0; u < 4; ++u) { u32x4 w; w.x = cvtpk(a[u][0], a[u][1]); w.y = cvtpk(a[u][2], a[u][3]); w.z = cvtpk(b[u][0], b[u][1]); w.w = cvtpk(b[u][2], b[u][3]);
            __builtin_nontemporal_store(w, (u32x4*)(dst + i + (size_t)u * NTHR * 8)); }
    }
}
__device__ __forceinline__ void rope_table(float* cosT, float* sinT) {
    const int tid = ltid();
    for (int i = blockIdx.x * NTHR + tid; i < SEQ * 64; i += gridDim.x * NTHR) {
        const int pos = i >> 6, d = i & 63;
        const float inv = (float)pow(10000.0, -(double)d / 64.0);
        const float ang = (float)pos * inv;
        cosT[i] = (float)cos((double)ang); sinT[i] = (float)sin((double)ang);
    }
}


namespace att {
constexpr int KBUF = 32768, VBUF = 32768, LV0 = 65536;
__device__ __forceinline__ int swap23(int k) { return (k & ~0xC) | ((k & 4) << 1) | ((k & 8) >> 1); }
__device__ __forceinline__ int v_rd_base(int lane) { return ((lane & 3) << 3) | (((lane >> 2) & 3) << 6) | (((lane >> 4) & 1) << 5) | (((lane >> 5) & 1) << 8); }
constexpr int v_rd_off(int d0, int ks, int half) { return d0 * 512 + ks * 8192 + half * 4096; }
__device__ __forceinline__ int crow(int r, int hi) { return (r & 3) + 8 * (r >> 2) + 4 * hi; }
#define SBAR() __builtin_amdgcn_sched_barrier(0)
#define WGBAR() do { asm volatile("" ::: "memory"); __builtin_amdgcn_s_barrier(); asm volatile("" ::: "memory"); } while (0)
#define GLDS(gp, lp) __builtin_amdgcn_global_load_lds((const unsigned*)(gp), (LAS unsigned*)(lp), 16, 0, 0)
#define PK4(P, B_, OUT) do { unsigned a0 = cvtpk(P[B_+0], P[B_+1]), a1 = cvtpk(P[B_+2], P[B_+3]);                          \
        unsigned b0 = cvtpk(P[B_+4], P[B_+5]), b1 = cvtpk(P[B_+6], P[B_+7]);                                             \
        auto r0 = __builtin_amdgcn_permlane32_swap(a0, b0, false, false); auto r1 = __builtin_amdgcn_permlane32_swap(a1, b1, false, false); \
        u32x4 w = {r0[0], r1[0], r0[1], r1[1]}; OUT = *reinterpret_cast<bf16x8*>(&w); } while (0)
#define TRRD(dst, addr, off) asm volatile("ds_read_b64_tr_b16 %0, %1 offset:%2" : "=&v"(dst) : "v"(addr), "i"(off) : "memory")
#define PV_DECL() s16x4 Al0, Al1, Al2, Al3, Ah0, Ah1, Ah2, Ah3, Bl0, Bl1, Bl2, Bl3, Bh0, Bh1, Bh2, Bh3
#define PV_LOAD(S_, vb, d0) do { constexpr int b_ = v_rd_off(d0, 0, 0);   \
        TRRD(S_##l0, vb, b_); TRRD(S_##h0, vb, b_ + 4096); TRRD(S_##l1, vb, b_ + 8192); TRRD(S_##h1, vb, b_ + 12288); \
        TRRD(S_##l2, vb, b_ + 16384); TRRD(S_##h2, vb, b_ + 20480); TRRD(S_##l3, vb, b_ + 24576); TRRD(S_##h3, vb, b_ + 28672); } while (0)
#define PV_MMA(o_, S_) do {             \
        o_ = __builtin_amdgcn_mfma_f32_32x32x16_bf16(pa0, (bf16x8){S_##l0[0], S_##l0[1], S_##l0[2], S_##l0[3], S_##h0[0], S_##h0[1], S_##h0[2], S_##h0[3]}, o_, 0, 0, 0);   \
        o_ = __builtin_amdgcn_mfma_f32_32x32x16_bf16(pa1, (bf16x8){S_##l1[0], S_##l1[1], S_##l1[2], S_##l1[3], S_##h1[0], S_##h1[1], S_##h1[2], S_##h1[3]}, o_, 0, 0, 0);   \
        o_ = __builtin_amdgcn_mfma_f32_32x32x16_bf16(pa2, (bf16x8){S_##l2[0], S_##l2[1], S_##l2[2], S_##l2[3], S_##h2[0], S_##h2[1], S_##h2[2], S_##h2[3]}, o_, 0, 0, 0);   \
        o_ = __builtin_amdgcn_mfma_f32_32x32x16_bf16(pa3, (bf16x8){S_##l3[0], S_##l3[1], S_##l3[2], S_##l3[3], S_##h3[0], S_##h3[1], S_##h3[2], S_##h3[3]}, o_, 0, 0, 0); } while (0)
#define LGKM(n) do { asm volatile("s_waitcnt lgkmcnt(" #n ")" ::: "memory"); SBAR(); } while (0)
struct KVSrc { const char* k0; const char* k1; unsigned vd0, vd1; int stride0, stride1, nsplit; };
__device__ __forceinline__ void kv_tile(const KVSrc& s, int j, const char*& kt, const char*& vt, int& strideB) {
    const bool first = j < s.nsplit;
    strideB = first ? s.stride0 : s.stride1;
    const size_t off = (size_t)(first ? j : j - s.nsplit) * 64 * strideB;
    kt = (first ? s.k0 : s.k1) + off; vt = kt + (first ? s.vd0 : s.vd1);
}
__device__ __forceinline__ void issue_V(LAS unsigned char* lds, int buf, const char* vt, int strideB, int wid, int lane) {
    const int kV = swap23(8 * wid + ((lane & 31) >> 2));
    const char* src = vt + (size_t)kV * strideB + (lane >> 5) * 64 + (lane & 3) * 16;
    LAS unsigned char* dst = lds + LV0 + buf * VBUF + wid * 4096;
#pragma unroll
    for (int jj = 0; jj < 4; ++jj) GLDS(src + jj * 128, dst + jj * 1024);
}

struct DItem { const bf16_t* q; KVSrc kv; int nt_lo, nt_hi; bf16_t* o; const float* kf; const float* vf; int desc; };
__device__ __forceinline__ void issue_K2(LAS unsigned char* lds, int buf, const char* kt, int strideB, int wid, int lane) {
    const int map = wid >> 2, jrow = wid & 3, rowL = 4 * jrow + (lane >> 4);
    const char* src = kt + (size_t)rowL * strideB + map * 256 + (((lane & 15) ^ rowL) << 4);
    LAS unsigned char* dst = lds + buf * KBUF + map * 16384 + jrow * 1024;
#pragma unroll
    for (int jj = 0; jj < 4; ++jj) GLDS(src + (size_t)jj * 16 * strideB, dst + jj * 4096);
}
struct Dma { const char* src; LAS unsigned char* dst; int sstep, dstep; };
__device__ __forceinline__ Dma dma_K2(LAS unsigned char* lds, int buf, const char* kt, int strideB, int wid, int lane) {
    const int map = wid >> 2, jrow = wid & 3, rowL = 4 * jrow + (lane >> 4);
    Dma d; d.src = kt + (size_t)rowL * strideB + map * 256 + (((lane & 15) ^ rowL) << 4); d.dst = lds + buf * KBUF + map * 16384 + jrow * 1024; d.sstep = 16 * strideB; d.dstep = 4096; return d; }
__device__ __forceinline__ Dma dma_V(LAS unsigned char* lds, int buf, const char* vt, int strideB, int wid, int lane) {
    const int kV = swap23(8 * wid + ((lane & 31) >> 2));
    Dma d; d.src = vt + (size_t)kV * strideB + (lane >> 5) * 64 + (lane & 3) * 16; d.dst = lds + LV0 + buf * VBUF + wid * 4096; d.sstep = 128; d.dstep = 1024; return d; }
#define DMA_PIECE(d_, jj) GLDS((d_).src + (size_t)(jj) * (d_).sstep, (d_).dst + (jj) * (d_).dstep)
constexpr float DSCALE = 0.08838834764831845f, DC2 = 1.4426950408889634f * DSCALE, DTHR = 6.f;

__device__ __forceinline__ void stage_load(f32x4 (&a)[16], const float* base  , int sw, int lane) {
    const float* p = base + (size_t)(16 * sw) * 1024 + lane * 4;
#pragma unroll
    for (int i = 0; i < 16; ++i) a[i] = __builtin_nontemporal_load((const f32x4*)(p + (size_t)i * 1024));
}
__device__ __forceinline__ void stage_write(const f32x4 (&a)[16], LAS unsigned char* lds, int kind, int buf, int sw, int lane) {
    const int c = lane >> 1, hf = (lane & 1) * 8;
#pragma unroll
    for (int i = 0; i < 16; ++i) {
        const int row = 16 * sw + i;
        const u32x2 w = {cvtpk(a[i][0], a[i][1]), cvtpk(a[i][2], a[i][3])};
        if (kind == 0) *(LAS u32x2*)(lds + buf * KBUF + (c >> 4) * 16384 + row * 256 + (((c & 15) ^ (row & 15)) << 4) + hf) = w;
        else { const int kk = swap23(row); *(LAS u32x2*)(lds + LV0 + buf * VBUF + ((kk >> 3) * 8 + (c >> 2)) * 512 + (kk & 7) * 64 + (c & 3) * 16 + hf) = w; }
    }
    asm volatile("s_waitcnt lgkmcnt(0)" ::: "memory");
}
__device__ const float g_post[2] = {0.8f, 0.52928698165641594f};
__device__ __forceinline__ void diff_item(const DItem& it, LAS unsigned char* lds, float lam, int lidx, const float* subw) {
    int tid = threadIdx.x; asm volatile("" : "+v"(tid));
    const int wid = __builtin_amdgcn_readfirstlane(tid >> 6), lane = tid & 63, r32 = lane & 31, hi = lane >> 5;
    const int grp = wid >> 2, wq = wid & 3;
    const int ntw = (wq < 2) ? it.nt_lo : it.nt_hi, NT = it.nt_lo > it.nt_hi ? it.nt_lo : it.nt_hi;
    LAS float* ws = (LAS float*)(lds + LDS_SCR) + wid * 64; LAS float* li_l = ws; LAS float* al_l = ws + 32;
    bf16x8 qr[8];
    if (ntw > 0) { const bf16_t* qp = it.q + (size_t)(wq * 32 + r32) * NIN + grp * 128 + hi * 8;
#pragma unroll
        for (int d0 = 0; d0 < 8; ++d0) qr[d0] = *(const bf16x8*)(qp + d0 * 16); }
    else {
#pragma unroll
        for (int d0 = 0; d0 < 8; ++d0) qr[d0] = (bf16x8){0, 0, 0, 0, 0, 0, 0, 0}; }
    f32x16 o[8];
#pragma unroll
    for (int d0 = 0; d0 < 8; ++d0) o[d0] = f32x16{};
    float m_reg = -1e30f, l_reg = 0.f;
    bf16x8 pa0 = {}, pa1 = {}, pa2 = {}, pa3 = {};
    const int xh = (r32 >> 1) & 7;
    LAS unsigned char* krd = lds + grp * 16384 + r32 * 256 + ((hi ^ (r32 & 1)) << 4);
    const int vb0 = (int)(uintptr_t)(lds + LV0) + v_rd_base(lane);
    const char* kt; const char* vt; int sB;
#define PH(t_) (it.desc ? NT - 1 - (t_) : (t_))
#define ISSUE_K(t_) do { kv_tile(it.kv, PH(t_), kt, vt, sB); issue_K2(lds, (t_) & 1, kt, sB, wid, lane); } while (0)
#define ISSUE_V(t_) do { kv_tile(it.kv, PH(t_), kt, vt, sB); issue_V(lds, (t_) & 1, vt, sB, wid, lane); } while (0)
#define WAIT_BAR(issued) do { if (issued) asm volatile("s_waitcnt vmcnt(4)" ::: "memory"); else asm volatile("s_waitcnt vmcnt(0)" ::: "memory"); WGBAR(); } while (0)
    const bool stg = it.kf != nullptr && wq >= 2;
    const int sw = (wid & 1) + 2 * grp;
#define F32T(j_) (it.kf != nullptr && (j_) < it.kv.nsplit)
    if (stg) {
        f32x4 a[16];
        if (F32T(0)) { stage_load(a, it.kf, sw, lane); asm volatile("s_waitcnt vmcnt(0)" ::: "memory"); stage_write(a, lds, 0, 0, sw, lane);
                       stage_load(a, it.vf, sw, lane); asm volatile("s_waitcnt vmcnt(0)" ::: "memory"); stage_write(a, lds, 1, 0, sw, lane); }
        else { ISSUE_K(0); ISSUE_V(0); asm volatile("s_waitcnt vmcnt(0)" ::: "memory"); }
        int n = 0;
        bool pend = false;
#define PREFETCH() do { const int j_ = 1 + (n >> 1); pend = j_ < NT && F32T(j_); if (pend) stage_load(a, ((n & 1) ? it.vf : it.kf) + (size_t)j_ * 64 * 1024, sw, lane); } while (0)
#define SEG() do { const int kind_ = n & 1, j_ = 1 + (n >> 1); bool did_ = false; \
            if (j_ < NT) { if (pend) { asm volatile("s_waitcnt vmcnt(0)" ::: "memory"); stage_write(a, lds, kind_, j_ & 1, sw, lane); } \
                           else { kv_tile(it.kv, j_, kt, vt, sB); Dma d_ = kind_ ? dma_V(lds, j_ & 1, vt, sB, wid, lane) : dma_K2(lds, j_ & 1, kt, sB, wid, lane); DMA_PIECE(d_, 0); DMA_PIECE(d_, 1); DMA_PIECE(d_, 2); DMA_PIECE(d_, 3); did_ = true; } } \
            ++n; PREFETCH(); \
            if (did_) asm volatile("s_waitcnt vmcnt(4)" ::: "memory"); else if (!pend) asm volatile("s_waitcnt vmcnt(0)" ::: "memory"); \
            WGBAR(); } while (0)
        PREFETCH();
        WGBAR();
        if (grp == 1) SEG();
        for (int t = 0; t < NT; ++t) { SEG(); SEG(); }
        if (grp == 0) WGBAR();
        asm volatile("s_waitcnt vmcnt(0) lgkmcnt(0)" ::: "memory"); WGBAR();
        asm volatile("s_waitcnt vmcnt(0) lgkmcnt(0)" ::: "memory"); WGBAR();
#undef SEG
#undef PREFETCH
        return;
    }
    if (!F32T(0)) { ISSUE_K(0); ISSUE_V(0); }
    asm volatile("s_waitcnt vmcnt(0)" ::: "memory"); WGBAR();
    if (grp == 1) { const bool is = 1 < NT && !F32T(1); if (is) ISSUE_K(1); WAIT_BAR(is); }
    for (int t = 0; t < NT; ++t) {
        const bool act = PH(t) < ntw;
        const bool isx = t + 1 < NT && !F32T(t + 1);
        Dma dx; dx.src = nullptr; dx.dst = lds; dx.sstep = 0; dx.dstep = 0;
        if (isx) { kv_tile(it.kv, PH(t + 1), kt, vt, sB); dx = (grp == 0) ? dma_K2(lds, (t + 1) & 1, kt, sB, wid, lane) : dma_V(lds, (t + 1) & 1, vt, sB, wid, lane); }
        if (!act && isx) { DMA_PIECE(dx, 0); DMA_PIECE(dx, 1); DMA_PIECE(dx, 2); DMA_PIECE(dx, 3); }
        if (act) {
            f32x16 p0 = f32x16{}, p1 = f32x16{};
            LAS unsigned char* kb = krd + (t & 1) * KBUF;
            __builtin_amdgcn_s_setprio(2);
            {
                const int kbv = (int)(uintptr_t)kb;
                bf16x8 K0, K1, K2, K3, K4;
#define KRD1(S_, i_) do { const int a_ = kbv + (((((i_) >> 1) ^ xh)) << 5); asm volatile("ds_read_b128 %0, %1 offset:%2" : "=&v"(S_) : "v"(a_), "i"(((i_) & 1) * 8192) : "memory"); } while (0)
                KRD1(K0, 0); KRD1(K1, 1); KRD1(K2, 2); KRD1(K3, 3); KRD1(K4, 4);
                LGKM(4); p0 = __builtin_amdgcn_mfma_f32_32x32x16_bf16(K0, qr[0], p0, 0, 0, 0); SBAR(); KRD1(K0, 5);
                LGKM(4); p1 = __builtin_amdgcn_mfma_f32_32x32x16_bf16(K1, qr[0], p1, 0, 0, 0); SBAR(); KRD1(K1, 6);
                LGKM(4); p0 = __builtin_amdgcn_mfma_f32_32x32x16_bf16(K2, qr[1], p0, 0, 0, 0); SBAR(); KRD1(K2, 7);
                LGKM(4); p1 = __builtin_amdgcn_mfma_f32_32x32x16_bf16(K3, qr[1], p1, 0, 0, 0); SBAR(); KRD1(K3, 8); if (isx) DMA_PIECE(dx, 0);
                LGKM(4); p0 = __builtin_amdgcn_mfma_f32_32x32x16_bf16(K4, qr[2], p0, 0, 0, 0); SBAR(); KRD1(K4, 9);
                LGKM(4); p1 = __builtin_amdgcn_mfma_f32_32x32x16_bf16(K0, qr[2], p1, 0, 0, 0); SBAR(); KRD1(K0, 10);
                LGKM(4); p0 = __builtin_amdgcn_mfma_f32_32x32x16_bf16(K1, qr[3], p0, 0, 0, 0); SBAR(); KRD1(K1, 11);
                LGKM(4); p1 = __builtin_amdgcn_mfma_f32_32x32x16_bf16(K2, qr[3], p1, 0, 0, 0); SBAR(); KRD1(K2, 12); if (isx) DMA_PIECE(dx, 1);
                LGKM(4); p0 = __builtin_amdgcn_mfma_f32_32x32x16_bf16(K3, qr[4], p0, 0, 0, 0); SBAR(); KRD1(K3, 13);
                LGKM(4); p1 = __builtin_amdgcn_mfma_f32_32x32x16_bf16(K4, qr[4], p1, 0, 0, 0); SBAR(); KRD1(K4, 14);
                LGKM(4); p0 = __builtin_amdgcn_mfma_f32_32x32x16_bf16(K0, qr[5], p0, 0, 0, 0); SBAR(); KRD1(K0, 15);
                LGKM(4); p1 = __builtin_amdgcn_mfma_f32_32x32x16_bf16(K1, qr[5], p1, 0, 0, 0); if (isx) DMA_PIECE(dx, 2);
                LGKM(3); p0 = __builtin_amdgcn_mfma_f32_32x32x16_bf16(K2, qr[6], p0, 0, 0, 0);
                LGKM(2); p1 = __builtin_amdgcn_mfma_f32_32x32x16_bf16(K3, qr[6], p1, 0, 0, 0);
                LGKM(1); p0 = __builtin_amdgcn_mfma_f32_32x32x16_bf16(K4, qr[7], p0, 0, 0, 0);
                LGKM(0); p1 = __builtin_amdgcn_mfma_f32_32x32x16_bf16(K0, qr[7], p1, 0, 0, 0); if (isx) DMA_PIECE(dx, 3);
#undef KRD1
            }
            __builtin_amdgcn_s_setprio(0);
            float pmax = p0[0];
#pragma unroll
            for (int r = 1; r < 16; ++r) pmax = fmaxf(pmax, p0[r]);
#pragma unroll
            for (int r = 0; r < 16; ++r) pmax = fmaxf(pmax, p1[r]);
            { auto rr = __builtin_amdgcn_permlane32_swap(__float_as_uint(pmax), __float_as_uint(pmax), false, false);
              pmax = fmaxf(__uint_as_float(rr[0]), __uint_as_float(rr[1])); }
            float mn, alpha;
            if (__builtin_expect(__all((pmax - m_reg) * DSCALE <= DTHR), 1)) { mn = m_reg; alpha = 1.f; }
            else { mn = fmaxf(m_reg, pmax); alpha = __builtin_amdgcn_exp2f((m_reg - mn) * DC2); m_reg = mn; }
            const float mnL = -mn * DC2;
            float ps = 0.f;
#pragma unroll
            for (int r = 0; r < 16; ++r) { p0[r] = __builtin_amdgcn_exp2f(fmaf(p0[r], DC2, mnL)); ps += p0[r]; }
#pragma unroll
            for (int r = 0; r < 16; ++r) { p1[r] = __builtin_amdgcn_exp2f(fmaf(p1[r], DC2, mnL)); ps += p1[r]; }
            { auto rr = __builtin_amdgcn_permlane32_swap(__float_as_uint(ps), __float_as_uint(ps), false, false);
              ps = __uint_as_float(rr[0]) + __uint_as_float(rr[1]); }
            l_reg = l_reg * alpha + ps;
            PK4(p0, 0, pa0); PK4(p0, 8, pa1); PK4(p1, 0, pa2); PK4(p1, 8, pa3);
            if (__any(alpha < 1.f)) {
                if (hi == 0) al_l[r32] = alpha;
                asm volatile("s_waitcnt lgkmcnt(0)" ::: "memory");
#pragma unroll
                for (int r = 0; r < 16; ++r) { const float a = al_l[crow(r, hi)];
#pragma unroll
                    for (int d0 = 0; d0 < 8; ++d0) o[d0][r] *= a; }
            }
        }
        WAIT_BAR(isx);
        const int ty = (grp == 0) ? t + 1 : t + 2;
        const bool isy = ty < NT && !F32T(ty);
        Dma dy; dy.src = nullptr; dy.dst = lds; dy.sstep = 0; dy.dstep = 0;
        if (isy) { if (grp == 0) { kv_tile(it.kv, PH(t + 1), kt, vt, sB); dy = dma_V(lds, (t + 1) & 1, vt, sB, wid, lane); } else { kv_tile(it.kv, PH(t + 2), kt, vt, sB); dy = dma_K2(lds, t & 1, kt, sB, wid, lane); } }
        if (!act && isy) { DMA_PIECE(dy, 0); DMA_PIECE(dy, 1); DMA_PIECE(dy, 2); DMA_PIECE(dy, 3); }
        if (act) {
            const int vb = vb0 + (t & 1) * VBUF;
            __builtin_amdgcn_s_setprio(1);
            s16x4 F0l, F0h, F1l, F1h, F2l, F2h, F3l, F3h, F4l, F4h, F5l, F5h, F6l, F6h, F7l, F7h;
            TRRD(F0l, vb, v_rd_off(0, 0, 0)); TRRD(F0h, vb, v_rd_off(0, 0, 1)); TRRD(F1l, vb, v_rd_off(0, 1, 0)); TRRD(F1h, vb, v_rd_off(0, 1, 1)); TRRD(F2l, vb, v_rd_off(0, 2, 0)); TRRD(F2h, vb, v_rd_off(0, 2, 1)); TRRD(F3l, vb, v_rd_off(0, 3, 0)); TRRD(F3h, vb, v_rd_off(0, 3, 1)); TRRD(F4l, vb, v_rd_off(1, 0, 0)); TRRD(F4h, vb, v_rd_off(1, 0, 1)); TRRD(F5l, vb, v_rd_off(1, 1, 0)); TRRD(F5h, vb, v_rd_off(1, 1, 1)); TRRD(F6l, vb, v_rd_off(1, 2, 0)); TRRD(F6h, vb, v_rd_off(1, 2, 1)); TRRD(F7l, vb, v_rd_off(1, 3, 0)); TRRD(F7h, vb, v_rd_off(1, 3, 1));
            LGKM(14); o[0] = __builtin_amdgcn_mfma_f32_32x32x16_bf16(pa0, (bf16x8){F0l[0], F0l[1], F0l[2], F0l[3], F0h[0], F0h[1], F0h[2], F0h[3]}, o[0], 0, 0, 0); SBAR(); TRRD(F0l, vb, v_rd_off(2, 0, 0)); TRRD(F0h, vb, v_rd_off(2, 0, 1));
            LGKM(14); o[0] = __builtin_amdgcn_mfma_f32_32x32x16_bf16(pa1, (bf16x8){F1l[0], F1l[1], F1l[2], F1l[3], F1h[0], F1h[1], F1h[2], F1h[3]}, o[0], 0, 0, 0); SBAR(); TRRD(F1l, vb, v_rd_off(2, 1, 0)); TRRD(F1h, vb, v_rd_off(2, 1, 1));
            LGKM(14); o[0] = __builtin_amdgcn_mfma_f32_32x32x16_bf16(pa2, (bf16x8){F2l[0], F2l[1], F2l[2], F2l[3], F2h[0], F2h[1], F2h[2], F2h[3]}, o[0], 0, 0, 0); SBAR(); TRRD(F2l, vb, v_rd_off(2, 2, 0)); TRRD(F2h, vb, v_rd_off(2, 2, 1));
            LGKM(14); o[0] = __builtin_amdgcn_mfma_f32_32x32x16_bf16(pa3, (bf16x8){F3l[0], F3l[1], F3l[2], F3l[3], F3h[0], F3h[1], F3h[2], F3h[3]}, o[0], 0, 0, 0); SBAR(); TRRD(F3l, vb, v_rd_off(2, 3, 0)); TRRD(F3h, vb, v_rd_off(2, 3, 1));
            LGKM(14); o[1] = __builtin_amdgcn_mfma_f32_32x32x16_bf16(pa0, (bf16x8){F4l[0], F4l[1], F4l[2], F4l[3], F4h[0], F4h[1], F4h[2], F4h[3]}, o[1], 0, 0, 0); SBAR(); TRRD(F4l, vb, v_rd_off(3, 0, 0)); TRRD(F4h, vb, v_rd_off(3, 0, 1));
            LGKM(14); o[1] = __builtin_amdgcn_mfma_f32_32x32x16_bf16(pa1, (bf16x8){F5l[0], F5l[1], F5l[2], F5l[3], F5h[0], F5h[1], F5h[2], F5h[3]}, o[1], 0, 0, 0); SBAR(); TRRD(F5l, vb, v_rd_off(3, 1, 0)); TRRD(F5h, vb, v_rd_off(3, 1, 1)); if (isy) DMA_PIECE(dy, 0);
            LGKM(14); o[1] = __builtin_amdgcn_mfma_f32_32x32x16_bf16(pa2, (bf16x8){F6l[0], F6l[1], F6l[2], F6l[3], F6h[0], F6h[1], F6h[2], F6h[3]}, o[1], 0, 0, 0); SBAR(); TRRD(F6l, vb, v_rd_off(3, 2, 0)); TRRD(F6h, vb, v_rd_off(3, 2, 1));
            LGKM(14); o[1] = __builtin_amdgcn_mfma_f32_32x32x16_bf16(pa3, (bf16x8){F7l[0], F7l[1], F7l[2], F7l[3], F7h[0], F7h[1], F7h[2], F7h[3]}, o[1], 0, 0, 0); SBAR(); TRRD(F7l, vb, v_rd_off(3, 3, 0)); TRRD(F7h, vb, v_rd_off(3, 3, 1));
            LGKM(14); o[2] = __builtin_amdgcn_mfma_f32_32x32x16_bf16(pa0, (bf16x8){F0l[0], F0l[1], F0l[2], F0l[3], F0h[0], F0h[1], F0h[2], F0h[3]}, o[2], 0, 0, 0); SBAR(); TRRD(F0l, vb, v_rd_off(4, 0, 0)); TRRD(F0h, vb, v_rd_off(4, 0, 1));
            LGKM(14); o[2] = __builtin_amdgcn_mfma_f32_32x32x16_bf16(pa1, (bf16x8){F1l[0], F1l[1], F1l[2], F1l[3], F1h[0], F1h[1], F1h[2], F1h[3]}, o[2], 0, 0, 0); SBAR(); TRRD(F1l, vb, v_rd_off(4, 1, 0)); TRRD(F1h, vb, v_rd_off(4, 1, 1));
            LGKM(14); o[2] = __builtin_amdgcn_mfma_f32_32x32x16_bf16(pa2, (bf16x8){F2l[0], F2l[1], F2l[2], F2l[3], F2h[0], F2h[1], F2h[2], F2h[3]}, o[2], 0, 0, 0); SBAR(); TRRD(F2l, vb, v_rd_off(4, 2, 0)); TRRD(F2h, vb, v_rd_off(4, 2, 1));
            LGKM(14); o[2] = __builtin_amdgcn_mfma_f32_32x32x16_bf16(pa3, (bf16x8){F3l[0], F3l[1], F3l[2], F3l[3], F3h[0], F3h[1], F3h[2], F3h[3]}, o[2], 0, 0, 0); SBAR(); TRRD(F3l, vb, v_rd_off(4, 3, 0)); TRRD(F3h, vb, v_rd_off(4, 3, 1));
            LGKM(14); o[3] = __builtin_amdgcn_mfma_f32_32x32x16_bf16(pa0, (bf16x8){F4l[0], F4l[1], F4l[2], F4l[3], F4h[0], F4h[1], F4h[2], F4h[3]}, o[3], 0, 0, 0); SBAR(); TRRD(F4l, vb, v_rd_off(5, 0, 0)); TRRD(F4h, vb, v_rd_off(5, 0, 1));
            LGKM(14); o[3] = __builtin_amdgcn_mfma_f32_32x32x16_bf16(pa1, (bf16x8){F5l[0], F5l[1], F5l[2], F5l[3], F5h[0], F5h[1], F5h[2], F5h[3]}, o[3], 0, 0, 0); SBAR(); TRRD(F5l, vb, v_rd_off(5, 1, 0)); TRRD(F5h, vb, v_rd_off(5, 1, 1)); if (isy) DMA_PIECE(dy, 1);
            LGKM(14); o[3] = __builtin_amdgcn_mfma_f32_32x32x16_bf16(pa2, (bf16x8){F6l[0], F6l[1], F6l[2], F6l[3], F6h[0], F6h[1], F6h[2], F6h[3]}, o[3], 0, 0, 0); SBAR(); TRRD(F6l, vb, v_rd_off(5, 2, 0)); TRRD(F6h, vb, v_rd_off(5, 2, 1));
            LGKM(14); o[3] = __builtin_amdgcn_mfma_f32_32x32x16_bf16(pa3, (bf16x8){F7l[0], F7l[1], F7l[2], F7l[3], F7h[0], F7h[1], F7h[2], F7h[3]}, o[3], 0, 0, 0); SBAR(); TRRD(F7l, vb, v_rd_off(5, 3, 0)); TRRD(F7h, vb, v_rd_off(5, 3, 1));
            LGKM(14); o[4] = __builtin_amdgcn_mfma_f32_32x32x16_bf16(pa0, (bf16x8){F0l[0], F0l[1], F0l[2], F0l[3], F0h[0], F0h[1], F0h[2], F0h[3]}, o[4], 0, 0, 0); SBAR(); TRRD(F0l, vb, v_rd_off(6, 0, 0)); TRRD(F0h, vb, v_rd_off(6, 0, 1));
            LGKM(14); o[4] = __builtin_amdgcn_mfma_f32_32x32x16_bf16(pa1, (bf16x8){F1l[0], F1l[1], F1l[2], F1l[3], F1h[0], F1h[1], F1h[2], F1h[3]}, o[4], 0, 0, 0); SBAR(); TRRD(F1l, vb, v_rd_off(6, 1, 0)); TRRD(F1h, vb, v_rd_off(6, 1, 1));
            LGKM(14); o[4] = __builtin_amdgcn_mfma_f32_32x32x16_bf16(pa2, (bf16x8){F2l[0], F2l[1], F2l[2], F2l[3], F2h[0], F2h[1], F2h[2], F2h[3]}, o[4], 0, 0, 0); SBAR(); TRRD(F2l, vb, v_rd_off(6, 2, 0)); TRRD(F2h, vb, v_rd_off(6, 2, 1));
            LGKM(14); o[4] = __builtin_amdgcn_mfma_f32_32x32x16_bf16(pa3, (bf16x8){F3l[0], F3l[1], F3l[2], F3l[3], F3h[0], F3h[1], F3h[2], F3h[3]}, o[4], 0, 0, 0); SBAR(); TRRD(F3l, vb, v_rd_off(6, 3, 0)); TRRD(F3h, vb, v_rd_off(6, 3, 1));
            LGKM(14); o[5] = __builtin_amdgcn_mfma_f32_32x32x16_bf16(pa0, (bf16x8){F4l[0], F4l[1], F4l[2], F4l[3], F4h[0], F4h[1], F4h[2], F4h[3]}, o[5], 0, 0, 0); SBAR(); TRRD(F4l, vb, v_rd_off(7, 0, 0)); TRRD(F4h, vb, v_rd_off(7, 0, 1));
            LGKM(14); o[5] = __builtin_amdgcn_mfma_f32_32x32x16_bf16(pa1, (bf16x8){F5l[0], F5l[1], F5l[2], F5l[3], F5h[0], F5h[1], F5h[2], F5h[3]}, o[5], 0, 0, 0); SBAR(); TRRD(F5l, vb, v_rd_off(7, 1, 0)); TRRD(F5h, vb, v_rd_off(7, 1, 1)); if (isy) DMA_PIECE(dy, 2);
            LGKM(14); o[5] = __builtin_amdgcn_mfma_f32_32x32x16_bf16(pa2, (bf16x8){F6l[0], F6l[1], F6l[2], F6l[3], F6h[0], F6h[1], F6h[2], F6h[3]}, o[5], 0, 0, 0); SBAR(); TRRD(F6l, vb, v_rd_off(7, 2, 0)); TRRD(F6h, vb, v_rd_off(7, 2, 1));
            LGKM(14); o[5] = __builtin_amdgcn_mfma_f32_32x32x16_bf16(pa3, (bf16x8){F7l[0], F7l[1], F7l[2], F7l[3], F7h[0], F7h[1], F7h[2], F7h[3]}, o[5], 0, 0, 0); SBAR(); TRRD(F7l, vb, v_rd_off(7, 3, 0)); TRRD(F7h, vb, v_rd_off(7, 3, 1));
            LGKM(14); o[6] = __builtin_amdgcn_mfma_f32_32x32x16_bf16(pa0, (bf16x8){F0l[0], F0l[1], F0l[2], F0l[3], F0h[0], F0h[1], F0h[2], F0h[3]}, o[6], 0, 0, 0);
            LGKM(12); o[6] = __builtin_amdgcn_mfma_f32_32x32x16_bf16(pa1, (bf16x8){F1l[0], F1l[1], F1l[2], F1l[3], F1h[0], F1h[1], F1h[2], F1h[3]}, o[6], 0, 0, 0);
            LGKM(10); o[6] = __builtin_amdgcn_mfma_f32_32x32x16_bf16(pa2, (bf16x8){F2l[0], F2l[1], F2l[2], F2l[3], F2h[0], F2h[1], F2h[2], F2h[3]}, o[6], 0, 0, 0);
            LGKM(8); o[6] = __builtin_amdgcn_mfma_f32_32x32x16_bf16(pa3, (bf16x8){F3l[0], F3l[1], F3l[2], F3l[3], F3h[0], F3h[1], F3h[2], F3h[3]}, o[6], 0, 0, 0);
            LGKM(6); o[7] = __builtin_amdgcn_mfma_f32_32x32x16_bf16(pa0, (bf16x8){F4l[0], F4l[1], F4l[2], F4l[3], F4h[0], F4h[1], F4h[2], F4h[3]}, o[7], 0, 0, 0);
            LGKM(4); o[7] = __builtin_amdgcn_mfma_f32_32x32x16_bf16(pa1, (bf16x8){F5l[0], F5l[1], F5l[2], F5l[3], F5h[0], F5h[1], F5h[2], F5h[3]}, o[7], 0, 0, 0); if (isy) DMA_PIECE(dy, 3);
            LGKM(2); o[7] = __builtin_amdgcn_mfma_f32_32x32x16_bf16(pa2, (bf16x8){F6l[0], F6l[1], F6l[2], F6l[3], F6h[0], F6h[1], F6h[2], F6h[3]}, o[7], 0, 0, 0);
            LGKM(0); o[7] = __builtin_amdgcn_mfma_f32_32x32x16_bf16(pa3, (bf16x8){F7l[0], F7l[1], F7l[2], F7l[3], F7h[0], F7h[1], F7h[2], F7h[3]}, o[7], 0, 0, 0);
            __builtin_amdgcn_s_setprio(0);
        }
        WAIT_BAR(isy);
    }
    if (grp == 0) WGBAR();
#undef ISSUE_K
#undef ISSUE_V
#undef PH
#undef F32T
    const int lane_e = __builtin_amdgcn_mbcnt_hi(~0u, __builtin_amdgcn_mbcnt_lo(~0u, 0u)), r32e = lane_e & 31, hie = lane_e >> 5;
    const bool active = ntw > 0;
    if (active) {
        if (hie == 0) li_l[r32e] = (grp == 0 ? 1.f : -lam) / l_reg;
        asm volatile("s_waitcnt lgkmcnt(0)" ::: "memory");
#pragma unroll
        for (int r = 0; r < 16; ++r) { const float a = li_l[crow(r, hie)];
#pragma unroll
            for (int d0 = 0; d0 < 8; ++d0) o[d0][r] *= a; }
        if (grp == 1) {
#pragma unroll
            for (int r = 0; r < 16; ++r) { LAS float* xp = (LAS float*)(lds + (wq * 32 + crow(r, hie)) * 1024) + r32e;
#pragma unroll
                for (int d0 = 0; d0 < 8; ++d0) xp[d0 * 32] = o[d0][r]; }
        }
    }
    asm volatile("s_waitcnt lgkmcnt(0)" ::: "memory"); WGBAR();
    if (active && grp == 0) {
        float sw[8];
        const float post = g_post[lidx];
#pragma unroll
        for (int d0 = 0; d0 < 8; ++d0) sw[d0] = subw[d0 * 32 + r32e] * post;
        const bf16_t* gp = it.q + 3072 + (size_t)(wq * 32) * NIN + lane_e * 4;
        bf16_t* op = it.o + (size_t)(wq * 32) * D + lane_e * 4;
        u32x2 gq[32];
#pragma unroll
        for (int rr = 0; rr < 32; ++rr) gq[rr] = *(const u32x2*)(gp + (size_t)rr * NIN);
#pragma unroll
        for (int r = 0; r < 16; ++r) {
            const int row = wq * 32 + crow(r, hie);
            LAS float* xp = (LAS float*)(lds + row * 1024) + r32e;
            float ssq = 0.f;
#pragma unroll
            for (int d0 = 0; d0 < 8; ++d0) { o[d0][r] += xp[d0 * 32]; ssq += o[d0][r] * o[d0][r]; }
            ssq = half_sum(ssq);
            const float rs = 1.0f / sqrtf(ssq * (1.0f / 256.0f) + EPS);
#pragma unroll
            for (int d0 = 0; d0 < 8; ++d0) xp[d0 * 32] = o[d0][r] * rs * sw[d0];
        }
#pragma unroll
        for (int rr = 0; rr < 32; ++rr) {
            const f32x4 t = *(const LAS f32x4*)(lds + (wq * 32 + rr) * 1024 + lane_e * 16);
            const float g0 = bf_lo(gq[rr][0]), g1 = bf_hi(gq[rr][0]), g2 = bf_lo(gq[rr][1]), g3 = bf_hi(gq[rr][1]);
            const u32x2 w = {cvtpk(t[0] * g0 / (1.0f + __expf(-g0)), t[1] * g1 / (1.0f + __expf(-g1))), cvtpk(t[2] * g2 / (1.0f + __expf(-g2)), t[3] * g3 / (1.0f + __expf(-g3)))};
            *(u32x2*)(op + (size_t)rr * D) = w;
        }
    }
    asm volatile("s_waitcnt vmcnt(0) lgkmcnt(0)" ::: "memory"); WGBAR();
}

struct SItem { const bf16_t* q; KVSrc kv; int P0, nrows, jstart; bf16_t* o; const float* kf; const float* vf; };
__device__ __forceinline__ void issue_K1(LAS unsigned char* lds, int buf, const char* kt, int strideB, int wid, int lane) {
    const int rowL = 2 * wid + (lane >> 5);
    const char* src = kt + (size_t)rowL * strideB + (((lane & 31) ^ rowL) << 4);
    LAS unsigned char* dst = lds + buf * KBUF + wid * 1024;
#pragma unroll
    for (int jj = 0; jj < 4; ++jj) GLDS(src + (size_t)jj * 16 * strideB, dst + jj * 8192);
}
__device__ __forceinline__ void issue_V16(LAS unsigned char* lds, int buf, const char* vt, int strideB, int wid, int lane) {
    const int rowL = 2 * wid + (lane >> 5), c16 = lane & 31;
    const char* src = vt + (size_t)rowL * strideB + ((((c16 >> 1) ^ (rowL & 7))) << 5) + ((c16 & 1) << 4);
    LAS unsigned char* dst = lds + LV0 + buf * VBUF + wid * 1024;
#pragma unroll
    for (int jj = 0; jj < 4; ++jj) GLDS(src + (size_t)jj * 16 * strideB, dst + jj * 8192);
}
__device__ __forceinline__ void load_tile_f32(LAS unsigned char* lds, int buf, const float* kf, const float* vf, int tid) {
    const int w = tid >> 6, L = tid & 63, c = L >> 1, hf = (L & 1) * 8;
    {   const float* p = kf + (size_t)(8 * w) * 1024 + L * 4; f32x4 a[8];
#pragma unroll
        for (int i = 0; i < 8; ++i) a[i] = __builtin_nontemporal_load((const f32x4*)(p + (size_t)i * 1024));
#pragma unroll
        for (int i = 0; i < 8; ++i) { const int row = 8 * w + i; const u32x2 v = {cvtpk(a[i][0], a[i][1]), cvtpk(a[i][2], a[i][3])};
            *(LAS u32x2*)(lds + buf * KBUF + row * 512 + ((c ^ (row & 15)) << 4) + hf) = v; } }
    {   const float* p = vf + (size_t)(8 * w) * 1024 + L * 4; f32x4 a[8];
#pragma unroll
        for (int i = 0; i < 8; ++i) a[i] = __builtin_nontemporal_load((const f32x4*)(p + (size_t)i * 1024));
#pragma unroll
        for (int i = 0; i < 8; ++i) { const int row = 8 * w + i; const u32x2 v = {cvtpk(a[i][0], a[i][1]), cvtpk(a[i][2], a[i][3])};
            *(LAS u32x2*)(lds + LV0 + buf * VBUF + row * 512 + ((((c >> 1) ^ (row & 7))) << 5) + ((c & 1) << 4) + hf) = v; } }
}
constexpr float LOG2E = 1.4426950408889634f, LN2 = 0.6931471805599453f;

__device__ __forceinline__ void sb_item(const SItem& it, LAS unsigned char* lds) {
    int tid = threadIdx.x; asm volatile("" : "+v"(tid));
    const int wid = __builtin_amdgcn_readfirstlane(tid >> 6), lane = tid & 63, j16 = lane & 15, q4 = lane >> 4;
    const int dh = wid >> 2, wq = wid & 3;
    const bool active = wq * 32 < it.nrows;
    volatile LAS unsigned* flags = (volatile LAS unsigned*)(lds + LDS_MISC + 64);
    bf16x8 qr[8];
    if (active) { const bf16_t* qp = it.q + (size_t)(wq * 32 + dh * 16 + j16) * NIN + q4 * 8;
#pragma unroll
        for (int ds = 0; ds < 8; ++ds) qr[ds] = *(const bf16x8*)(qp + ds * 32); }
    else {
#pragma unroll
        for (int ds = 0; ds < 8; ++ds) qr[ds] = (bf16x8){0, 0, 0, 0, 0, 0, 0, 0}; }
    f32x4 o[16];
#pragma unroll
    for (int cb = 0; cb < 16; ++cb) o[cb] = (f32x4){0.f, 0.f, 0.f, 0.f};
    float C = 0.f;
    const int P0w = it.P0 + 32 * wq + 16 * dh, jw = P0w >> 6, lim = (P0w & 63) + j16;
    const int xh2 = j16 >> 2;
    LAS unsigned char* krd = lds + j16 * 512 + ((q4 ^ (j16 & 3)) << 4);
    const int rx = 4 * (q4 & 1) + ((lane >> 2) & 3);
    const int vb0 = (int)(uintptr_t)(lds + LV0) + (4 * q4 + ((lane >> 2) & 3)) * 512 + 8 * (lane & 3);
    const char* kt; const char* vt; int sB;
    bool done = !active;
    kv_tile(it.kv, it.jstart, kt, vt, sB); issue_K1(lds, 0, kt, sB, wid, lane); issue_V16(lds, 0, vt, sB, wid, lane);
    asm volatile("s_waitcnt vmcnt(0)" ::: "memory"); WGBAR();
    for (int itn = 0;; ++itn) {
        const int j = it.jstart - itn, b = itn & 1;
        const bool nxt_f32 = j > 0 && it.kf != nullptr && (j - 1) < it.kv.nsplit;
        if (j > 0 && !nxt_f32) { kv_tile(it.kv, j - 1, kt, vt, sB); issue_K1(lds, b ^ 1, kt, sB, wid, lane); issue_V16(lds, b ^ 1, vt, sB, wid, lane); }
        if (!done && j <= jw) {
            const bool diag = (j == jw);
            f32x4 st[4];
#pragma unroll
            for (int kb = 0; kb < 4; ++kb) st[kb] = (f32x4){0.f, 0.f, 0.f, 0.f};
            const int kbv = (int)(uintptr_t)(krd + b * KBUF);
            bf16x8 K0, K1, K2, K3, K4, K5;
#define KRD1(S_, i_) do { const int a_ = kbv + ((((((i_) & 7) & 3) ^ xh2)) << 6); asm volatile("ds_read_b128 %0, %1 offset:%2" : "=&v"(S_) : "v"(a_), "i"(((i_) >> 3) * 8192 + (((i_) & 7) >> 2) * 256) : "memory"); } while (0)
            KRD1(K0, 0); KRD1(K1, 1); KRD1(K2, 2); KRD1(K3, 3); KRD1(K4, 4); KRD1(K5, 5);
            LGKM(5); st[0] = __builtin_amdgcn_mfma_f32_16x16x32_bf16(K0, qr[0], st[0], 0, 0, 0); SBAR(); KRD1(K0, 6);
            LGKM(5); st[0] = __builtin_amdgcn_mfma_f32_16x16x32_bf16(K1, qr[1], st[0], 0, 0, 0); SBAR(); KRD1(K1, 7);
            LGKM(5); st[0] = __builtin_amdgcn_mfma_f32_16x16x32_bf16(K2, qr[2], st[0], 0, 0, 0); SBAR(); KRD1(K2, 8);
            LGKM(5); st[0] = __builtin_amdgcn_mfma_f32_16x16x32_bf16(K3, qr[3], st[0], 0, 0, 0); SBAR(); KRD1(K3, 9);
            LGKM(5); st[0] = __builtin_amdgcn_mfma_f32_16x16x32_bf16(K4, qr[4], st[0], 0, 0, 0); SBAR(); KRD1(K4, 10);
            LGKM(5); st[0] = __builtin_amdgcn_mfma_f32_16x16x32_bf16(K5, qr[5], st[0], 0, 0, 0); SBAR(); KRD1(K5, 11);
            LGKM(5); st[0] = __builtin_amdgcn_mfma_f32_16x16x32_bf16(K0, qr[6], st[0], 0, 0, 0); SBAR(); KRD1(K0, 12);
            LGKM(5); st[0] = __builtin_amdgcn_mfma_f32_16x16x32_bf16(K1, qr[7], st[0], 0, 0, 0); SBAR(); KRD1(K1, 13);
            LGKM(5); st[1] = __builtin_amdgcn_mfma_f32_16x16x32_bf16(K2, qr[0], st[1], 0, 0, 0); SBAR(); KRD1(K2, 14);
            LGKM(5); st[1] = __builtin_amdgcn_mfma_f32_16x16x32_bf16(K3, qr[1], st[1], 0, 0, 0); SBAR(); KRD1(K3, 15);
            LGKM(5); st[1] = __builtin_amdgcn_mfma_f32_16x16x32_bf16(K4, qr[2], st[1], 0, 0, 0); SBAR(); KRD1(K4, 16);
            LGKM(5); st[1] = __builtin_amdgcn_mfma_f32_16x16x32_bf16(K5, qr[3], st[1], 0, 0, 0); SBAR(); KRD1(K5, 17);
            LGKM(5); st[1] = __builtin_amdgcn_mfma_f32_16x16x32_bf16(K0, qr[4], st[1], 0, 0, 0); SBAR(); KRD1(K0, 18);
            LGKM(5); st[1] = __builtin_amdgcn_mfma_f32_16x16x32_bf16(K1, qr[5], st[1], 0, 0, 0); SBAR(); KRD1(K1, 19);
            LGKM(5); st[1] = __builtin_amdgcn_mfma_f32_16x16x32_bf16(K2, qr[6], st[1], 0, 0, 0); SBAR(); KRD1(K2, 20);
            LGKM(5); st[1] = __builtin_amdgcn_mfma_f32_16x16x32_bf16(K3, qr[7], st[1], 0, 0, 0); SBAR(); KRD1(K3, 21);
            LGKM(5); st[2] = __builtin_amdgcn_mfma_f32_16x16x32_bf16(K4, qr[0], st[2], 0, 0, 0); SBAR(); KRD1(K4, 22);
            LGKM(5); st[2] = __builtin_amdgcn_mfma_f32_16x16x32_bf16(K5, qr[1], st[2], 0, 0, 0); SBAR(); KRD1(K5, 23);
            LGKM(5); st[2] = __builtin_amdgcn_mfma_f32_16x16x32_bf16(K0, qr[2], st[2], 0, 0, 0); SBAR(); KRD1(K0, 24);
            LGKM(5); st[2] = __builtin_amdgcn_mfma_f32_16x16x32_bf16(K1, qr[3], st[2], 0, 0, 0); SBAR(); KRD1(K1, 25);
            LGKM(5); st[2] = __builtin_amdgcn_mfma_f32_16x16x32_bf16(K2, qr[4], st[2], 0, 0, 0); SBAR(); KRD1(K2, 26);
            LGKM(5); st[2] = __builtin_amdgcn_mfma_f32_16x16x32_bf16(K3, qr[5], st[2], 0, 0, 0); SBAR(); KRD1(K3, 27);
            LGKM(5); st[2] = __builtin_amdgcn_mfma_f32_16x16x32_bf16(K4, qr[6], st[2], 0, 0, 0); SBAR(); KRD1(K4, 28);
            LGKM(5); st[2] = __builtin_amdgcn_mfma_f32_16x16x32_bf16(K5, qr[7], st[2], 0, 0, 0); SBAR(); KRD1(K5, 29);
            LGKM(5); st[3] = __builtin_amdgcn_mfma_f32_16x16x32_bf16(K0, qr[0], st[3], 0, 0, 0); SBAR(); KRD1(K0, 30);
            LGKM(5); st[3] = __builtin_amdgcn_mfma_f32_16x16x32_bf16(K1, qr[1], st[3], 0, 0, 0); SBAR(); KRD1(K1, 31);
            LGKM(5); st[3] = __builtin_amdgcn_mfma_f32_16x16x32_bf16(K2, qr[2], st[3], 0, 0, 0);
            LGKM(4); st[3] = __builtin_amdgcn_mfma_f32_16x16x32_bf16(K3, qr[3], st[3], 0, 0, 0);
            LGKM(3); st[3] = __builtin_amdgcn_mfma_f32_16x16x32_bf16(K4, qr[4], st[3], 0, 0, 0);
            LGKM(2); st[3] = __builtin_amdgcn_mfma_f32_16x16x32_bf16(K5, qr[5], st[3], 0, 0, 0);
            LGKM(1); st[3] = __builtin_amdgcn_mfma_f32_16x16x32_bf16(K0, qr[6], st[3], 0, 0, 0);
            LGKM(0); st[3] = __builtin_amdgcn_mfma_f32_16x16x32_bf16(K1, qr[7], st[3], 0, 0, 0);
#undef KRD1
            f32x4 L[4];
#pragma unroll
            for (int kb = 0; kb < 4; ++kb)
#pragma unroll
                for (int e = 0; e < 4; ++e) { const float z = st[kb][e]; const float t_ = __builtin_amdgcn_exp2f(-fabsf(z) * LOG2E); L[kb][e] = -(fmaxf(z, 0.f) + LN2 * __builtin_amdgcn_logf(1.0f + t_)); }
            if (diag) {
#pragma unroll
                for (int kb = 0; kb < 4; ++kb)
#pragma unroll
                    for (int e = 0; e < 4; ++e) if (16 * kb + 4 * q4 + e >= lim) { L[kb][e] = 0.f; st[kb][e] = -1e30f; }
            }
            float run = C;
#pragma unroll
            for (int kb = 3; kb >= 0; --kb) {
                L[kb][2] += L[kb][3]; L[kb][1] += L[kb][2]; L[kb][0] += L[kb][1];
                const float g = L[kb][0];
                const float p1 = xor_lane<16>(g);
                const float pair = g + p1;
                float opair; { auto rr = __builtin_amdgcn_permlane32_swap(__float_as_uint(pair), __float_as_uint(pair), false, false); opair = (q4 & 2) ? __uint_as_float(rr[0]) : __uint_as_float(rr[1]); }
                const float off = run + ((q4 & 1) ? 0.f : p1) + ((q4 & 2) ? 0.f : opair);
#pragma unroll
                for (int e = 0; e < 4; ++e) st[kb][e] = __builtin_amdgcn_exp2f((st[kb][e] + L[kb][e] + off) * LOG2E);
                run += pair + opair;
            }
            C = run;
            bf16x8 pa[2];
#pragma unroll
            for (int s = 0; s < 2; ++s) { u32x4 w = {cvtpk(st[2 * s][0], st[2 * s][1]), cvtpk(st[2 * s][2], st[2 * s][3]), cvtpk(st[2 * s + 1][0], st[2 * s + 1][1]), cvtpk(st[2 * s + 1][2], st[2 * s + 1][3])};
                pa[s] = *reinterpret_cast<bf16x8*>(&w); }
            const int vbt = vb0 + b * VBUF;
            s16x4 F0l, F0h, F1l, F1h, F2l, F2h, F3l, F3h, F4l, F4h, F5l, F5h, F6l, F6h, F7l, F7h;
#define VRD1(S_, i_) do { const int a_ = vbt + (((((i_) >> 1) & 7) ^ rx) << 5); asm volatile("ds_read_b64_tr_b16 %0, %2 offset:%3\n\tds_read_b64_tr_b16 %1, %2 offset:%4" : "=&v"(S_##l), "=&v"(S_##h) : "v"(a_), "i"(((i_) >> 4) * 256 + ((i_) & 1) * 16384), "i"(((i_) >> 4) * 256 + ((i_) & 1) * 16384 + 8192) : "memory"); } while (0)
            VRD1(F0, 0); VRD1(F1, 1); VRD1(F2, 2); VRD1(F3, 3); VRD1(F4, 4); VRD1(F5, 5); VRD1(F6, 6); VRD1(F7, 7);
            LGKM(14); o[0] = __builtin_amdgcn_mfma_f32_16x16x32_bf16(pa[0], (bf16x8){F0l[0], F0l[1], F0l[2], F0l[3], F0h[0], F0h[1], F0h[2], F0h[3]}, o[0], 0, 0, 0); SBAR(); VRD1(F0, 8);
            LGKM(14); o[0] = __builtin_amdgcn_mfma_f32_16x16x32_bf16(pa[1], (bf16x8){F1l[0], F1l[1], F1l[2], F1l[3], F1h[0], F1h[1], F1h[2], F1h[3]}, o[0], 0, 0, 0); SBAR(); VRD1(F1, 9);
            LGKM(14); o[1] = __builtin_amdgcn_mfma_f32_16x16x32_bf16(pa[0], (bf16x8){F2l[0], F2l[1], F2l[2], F2l[3], F2h[0], F2h[1], F2h[2], F2h[3]}, o[1], 0, 0, 0); SBAR(); VRD1(F2, 10);
            LGKM(14); o[1] = __builtin_amdgcn_mfma_f32_16x16x32_bf16(pa[1], (bf16x8){F3l[0], F3l[1], F3l[2], F3l[3], F3h[0], F3h[1], F3h[2], F3h[3]}, o[1], 0, 0, 0); SBAR(); VRD1(F3, 11);
            LGKM(14); o[2] = __builtin_amdgcn_mfma_f32_16x16x32_bf16(pa[0], (bf16x8){F4l[0], F4l[1], F4l[2], F4l[3], F4h[0], F4h[1], F4h[2], F4h[3]}, o[2], 0, 0, 0); SBAR(); VRD1(F4, 12);
            LGKM(14); o[2] = __builtin_amdgcn_mfma_f32_16x16x32_bf16(pa[1], (bf16x8){F5l[0], F5l[1], F5l[2], F5l[3], F5h[0], F5h[1], F5h[2], F5h[3]}, o[2], 0, 0, 0); SBAR(); VRD1(F5, 13);
            LGKM(14); o[3] = __builtin_amdgcn_mfma_f32_16x16x32_bf16(pa[0], (bf16x8){F6l[0], F6l[1], F6l[2], F6l[3], F6h[0], F6h[1], F6h[2], F6h[3]}, o[3], 0, 0, 0); SBAR(); VRD1(F6, 14);
            LGKM(14); o[3] = __builtin_amdgcn_mfma_f32_16x16x32_bf16(pa[1], (bf16x8){F7l[0], F7l[1], F7l[2], F7l[3], F7h[0], F7h[1], F7h[2], F7h[3]}, o[3], 0, 0, 0); SBAR(); VRD1(F7, 15);
            LGKM(14); o[4] = __builtin_amdgcn_mfma_f32_16x16x32_bf16(pa[0], (bf16x8){F0l[0], F0l[1], F0l[2], F0l[3], F0h[0], F0h[1], F0h[2], F0h[3]}, o[4], 0, 0, 0); SBAR(); VRD1(F0, 16);
            LGKM(14); o[4] = __builtin_amdgcn_mfma_f32_16x16x32_bf16(pa[1], (bf16x8){F1l[0], F1l[1], F1l[2], F1l[3], F1h[0], F1h[1], F1h[2], F1h[3]}, o[4], 0, 0, 0); SBAR(); VRD1(F1, 17);
            LGKM(14); o[5] = __builtin_amdgcn_mfma_f32_16x16x32_bf16(pa[0], (bf16x8){F2l[0], F2l[1], F2l[2], F2l[3], F2h[0], F2h[1], F2h[2], F2h[3]}, o[5], 0, 0, 0); SBAR(); VRD1(F2, 18);
            LGKM(14); o[5] = __builtin_amdgcn_mfma_f32_16x16x32_bf16(pa[1], (bf16x8){F3l[0], F3l[1], F3l[2], F3l[3], F3h[0], F3h[1], F3h[2], F3h[3]}, o[5], 0, 0, 0); SBAR(); VRD1(F3, 19);
            LGKM(14); o[6] = __builtin_amdgcn_mfma_f32_16x16x32_bf16(pa[0], (bf16x8){F4l[0], F4l[1], F4l[2], F4l[3], F4h[0], F4h[1], F4h[2], F4h[3]}, o[6], 0, 0, 0); SBAR(); VRD1(F4, 20);
            LGKM(14); o[6] = __builtin_amdgcn_mfma_f32_16x16x32_bf16(pa[1], (bf16x8){F5l[0], F5l[1], F5l[2], F5l[3], F5h[0], F5h[1], F5h[2], F5h[3]}, o[6], 0, 0, 0); SBAR(); VRD1(F5, 21);
            LGKM(14); o[7] = __builtin_amdgcn_mfma_f32_16x16x32_bf16(pa[0], (bf16x8){F6l[0], F6l[1], F6l[2], F6l[3], F6h[0], F6h[1], F6h[2], F6h[3]}, o[7], 0, 0, 0); SBAR(); VRD1(F6, 22);
            LGKM(14); o[7] = __builtin_amdgcn_mfma_f32_16x16x32_bf16(pa[1], (bf16x8){F7l[0], F7l[1], F7l[2], F7l[3], F7h[0], F7h[1], F7h[2], F7h[3]}, o[7], 0, 0, 0); SBAR(); VRD1(F7, 23);
            LGKM(14); o[8] = __builtin_amdgcn_mfma_f32_16x16x32_bf16(pa[0], (bf16x8){F0l[0], F0l[1], F0l[2], F0l[3], F0h[0], F0h[1], F0h[2], F0h[3]}, o[8], 0, 0, 0); SBAR(); VRD1(F0, 24);
            LGKM(14); o[8] = __builtin_amdgcn_mfma_f32_16x16x32_bf16(pa[1], (bf16x8){F1l[0], F1l[1], F1l[2], F1l[3], F1h[0], F1h[1], F1h[2], F1h[3]}, o[8], 0, 0, 0); SBAR(); VRD1(F1, 25);
            LGKM(14); o[9] = __builtin_amdgcn_mfma_f32_16x16x32_bf16(pa[0], (bf16x8){F2l[0], F2l[1], F2l[2], F2l[3], F2h[0], F2h[1], F2h[2], F2h[3]}, o[9], 0, 0, 0); SBAR(); VRD1(F2, 26);
            LGKM(14); o[9] = __builtin_amdgcn_mfma_f32_16x16x32_bf16(pa[1], (bf16x8){F3l[0], F3l[1], F3l[2], F3l[3], F3h[0], F3h[1], F3h[2], F3h[3]}, o[9], 0, 0, 0); SBAR(); VRD1(F3, 27);
            LGKM(14); o[10] = __builtin_amdgcn_mfma_f32_16x16x32_bf16(pa[0], (bf16x8){F4l[0], F4l[1], F4l[2], F4l[3], F4h[0], F4h[1], F4h[2], F4h[3]}, o[10], 0, 0, 0); SBAR(); VRD1(F4, 28);
            LGKM(14); o[10] = __builtin_amdgcn_mfma_f32_16x16x32_bf16(pa[1], (bf16x8){F5l[0], F5l[1], F5l[2], F5l[3], F5h[0], F5h[1], F5h[2], F5h[3]}, o[10], 0, 0, 0); SBAR(); VRD1(F5, 29);
            LGKM(14); o[11] = __builtin_amdgcn_mfma_f32_16x16x32_bf16(pa[0], (bf16x8){F6l[0], F6l[1], F6l[2], F6l[3], F6h[0], F6h[1], F6h[2], F6h[3]}, o[11], 0, 0, 0); SBAR(); VRD1(F6, 30);
            LGKM(14); o[11] = __builtin_amdgcn_mfma_f32_16x16x32_bf16(pa[1], (bf16x8){F7l[0], F7l[1], F7l[2], F7l[3], F7h[0], F7h[1], F7h[2], F7h[3]}, o[11], 0, 0, 0); SBAR(); VRD1(F7, 31);
            LGKM(14); o[12] = __builtin_amdgcn_mfma_f32_16x16x32_bf16(pa[0], (bf16x8){F0l[0], F0l[1], F0l[2], F0l[3], F0h[0], F0h[1], F0h[2], F0h[3]}, o[12], 0, 0, 0);
            LGKM(12); o[12] = __builtin_amdgcn_mfma_f32_16x16x32_bf16(pa[1], (bf16x8){F1l[0], F1l[1], F1l[2], F1l[3], F1h[0], F1h[1], F1h[2], F1h[3]}, o[12], 0, 0, 0);
            LGKM(10); o[13] = __builtin_amdgcn_mfma_f32_16x16x32_bf16(pa[0], (bf16x8){F2l[0], F2l[1], F2l[2], F2l[3], F2h[0], F2h[1], F2h[2], F2h[3]}, o[13], 0, 0, 0);
            LGKM(8); o[13] = __builtin_amdgcn_mfma_f32_16x16x32_bf16(pa[1], (bf16x8){F3l[0], F3l[1], F3l[2], F3l[3], F3h[0], F3h[1], F3h[2], F3h[3]}, o[13], 0, 0, 0);
            LGKM(6); o[14] = __builtin_amdgcn_mfma_f32_16x16x32_bf16(pa[0], (bf16x8){F4l[0], F4l[1], F4l[2], F4l[3], F4h[0], F4h[1], F4h[2], F4h[3]}, o[14], 0, 0, 0);
            LGKM(4); o[14] = __builtin_amdgcn_mfma_f32_16x16x32_bf16(pa[1], (bf16x8){F5l[0], F5l[1], F5l[2], F5l[3], F5h[0], F5h[1], F5h[2], F5h[3]}, o[14], 0, 0, 0);
            LGKM(2); o[15] = __builtin_amdgcn_mfma_f32_16x16x32_bf16(pa[0], (bf16x8){F6l[0], F6l[1], F6l[2], F6l[3], F6h[0], F6h[1], F6h[2], F6h[3]}, o[15], 0, 0, 0);
            LGKM(0); o[15] = __builtin_amdgcn_mfma_f32_16x16x32_bf16(pa[1], (bf16x8){F7l[0], F7l[1], F7l[2], F7l[3], F7h[0], F7h[1], F7h[2], F7h[3]}, o[15], 0, 0, 0);
#undef VRD1
            if (__all(C <= -104.f)) done = true;
        }
        if (nxt_f32) load_tile_f32(lds, b ^ 1, it.kf + (size_t)(j - 1) * 64 * 1024, it.vf + (size_t)(j - 1) * 64 * 1024, tid);
        if (lane == 0) flags[b * 8 + wid] = done ? 1u : 0u;
        asm volatile("s_waitcnt vmcnt(0) lgkmcnt(0)" ::: "memory"); WGBAR();
        if (j == 0) break;
        const unsigned f = (lane < 8) ? flags[b * 8 + lane] : 1u;
        if (!__any(f == 0u)) break;
    }
    asm volatile("s_waitcnt vmcnt(0) lgkmcnt(0)" ::: "memory"); WGBAR();
    if (active) {
        const int rsel = lane >> 5, c0 = (lane & 31) * 8;
        const bf16_t* gp = it.q + 3072 + (size_t)(wq * 32 + dh * 16 + rsel) * NIN + c0;
        u32x4 gv[8];
#pragma unroll
        for (int i = 0; i < 8; ++i) gv[i] = *(const u32x4*)(gp + (size_t)(2 * i) * NIN);
        LAS unsigned char* wb = lds + wid * 16384;
#pragma unroll
        for (int e = 0; e < 4; ++e) { const int ae = q4 * 4096 + q4 * 64 + e * 1024 + ((j16 ^ (e << 2)) << 2);
#pragma unroll
            for (int cb = 0; cb < 16; ++cb) *(LAS float*)(wb + (ae ^ (cb << 6))) = o[cb][e]; }
        const int l0 = rsel * 1024 + (((lane & 31) * 32) ^ (rsel << 4));
        bf16_t* op = it.o + (size_t)(wq * 32 + dh * 16 + rsel) * D + c0;
#pragma unroll
        for (int i = 0; i < 8; ++i) {
            const int ad = 2 * i * 1024 + (l0 ^ (((i >> 1) << 6) ^ ((i & 1) << 5)));
            const f32x4 oa = *(const LAS f32x4*)(wb + ad), ob = *(const LAS f32x4*)(wb + (ad ^ 16));
            u32x4 w;
#pragma unroll
            for (int k = 0; k < 4; ++k) { const float g0 = bf_lo(gv[i][k]), g1 = bf_hi(gv[i][k]);
                const float x0 = (k < 2) ? oa[2 * k] : ob[2 * k - 4], x1 = (k < 2) ? oa[2 * k + 1] : ob[2 * k - 3];
                w[k] = cvtpk(x0 * g0 / (1.0f + __expf(-g0)), x1 * g1 / (1.0f + __expf(-g1))); }
            *(u32x4*)(op + (size_t)(2 * i) * D) = w;
        }
    }
    WGBAR();
}
}

struct DSched { unsigned short it[32][8]; unsigned char n[32]; };
__device__ const DSched g_dsched = { {{127, 320, 42, 284, 0, 0, 0, 0}, {126, 321, 37, 259, 128, 0, 0, 0}, {125, 322, 49, 278, 0, 0, 0, 0}, {124, 323, 43, 256, 129, 0, 0, 0}, {123, 324, 36, 287, 0, 0, 0, 0}, {122, 325, 39, 258, 130, 0, 0, 0}, {121, 326, 32, 266, 131, 0, 0, 0}, {120, 327, 38, 286, 0, 0, 0, 0}, {119, 328, 55, 272, 0, 0, 0, 0}, {118, 329, 60, 267, 0, 0, 0, 0}, {117, 330, 51, 276, 0, 0, 0, 0}, {116, 331, 53, 274, 0, 0, 0, 0}, {115, 332, 61, 264, 0, 0, 0, 0}, {114, 333, 47, 280, 0, 0, 0, 0}, {113, 334, 33, 265, 132, 0, 0, 0}, {112, 335, 35, 261, 133, 0, 0, 0}, {111, 336, 63, 260, 0, 0, 0, 0}, {110, 337, 41, 257, 134, 0, 0, 0}, {109, 338, 45, 282, 0, 0, 0, 0}, {108, 339, 50, 277, 0, 0, 0, 0}, {107, 340, 54, 273, 0, 0, 0, 0}, {106, 341, 40, 285, 0, 0, 0, 0}, {105, 342, 58, 269, 0, 0, 0, 0}, {104, 343, 59, 268, 0, 0, 0, 0}, {103, 344, 62, 262, 0, 0, 0, 0}, {102, 345, 57, 270, 0, 0, 0, 0}, {101, 346, 46, 281, 0, 0, 0, 0}, {100, 347, 56, 271, 0, 0, 0, 0}, {99, 348, 52, 275, 0, 0, 0, 0}, {98, 349, 44, 283, 0, 0, 0, 0}, {97, 350, 34, 263, 135, 0, 0, 0}, {96, 351, 48, 279, 0, 0, 0, 0}}, {4, 5, 4, 5, 4, 5, 5, 4, 4, 4, 4, 4, 4, 4, 5, 5, 4, 5, 4, 4, 4, 4, 4, 4, 4, 4, 4, 4, 4, 4, 5, 4} };

#define CAS __attribute__((address_space(4)))
#define KARGS() const CAS unsigned char* kp_ = (const CAS unsigned char*)__builtin_amdgcn_kernarg_segment_ptr(); asm volatile("" : "+s"(kp_))
#define KIN(i) as_global(*(const float* const CAS*)(kp_ + 8 * (i)))
#define KOUT() as_global(*(float* const CAS*)(kp_ + 80))
#define KWS() as_global(*(unsigned char* const CAS*)(kp_ + 88))
__global__ void __launch_bounds__(NTHR, 2) fwd(const float* in0, const float* in1, const float* in2, const float* in3, const float* in4, const float* in5, const float* in6,
                                               const float* in7, const float* in8, const float* in9, float* out_, unsigned char* ws_, int ph_lo, int ph_hi) {
    extern __shared__ __attribute__((aligned(16))) unsigned char lds_raw[];
    LAS unsigned char* lds = (LAS unsigned char*)lds_raw;
    const int G = gridDim.x, bx = blockIdx.x;
    volatile LAS unsigned* misc = (volatile LAS unsigned*)(lds + LDS_MISC);
    if (threadIdx.x < 64) misc[threadIdx.x] = 0u;
    __syncthreads();
    XcdBarrier bar; bar.x = 0; bar.st = misc;
    { KARGS(); bar.bar = (unsigned*)(KWS() + WS_CTL) + CW_BAR; }
    if (!MK_PER_PHASE) bar = xcd_barrier_post(bar.bar, misc);
#define GRID_BAR() do { if (!MK_PER_PHASE) xcd_barrier(bar); } while (0)
    int lo, hi_; { KARGS(); lo = *(const int CAS*)(kp_ + 96); hi_ = *(const int CAS*)(kp_ + 100); }
#define IN(k) (lo <= (k) && (k) < hi_)
#define PHASE_PTRS() \
    KARGS(); unsigned char* ws = KWS(); \
    unsigned* ctl = (unsigned*)(ws + WS_CTL); (void)ctl; \
    bf16_t* H = (bf16_t*)(ws + WS_H); bf16_t* QKVG = (bf16_t*)(ws + WS_QKVG); float* Y = (float*)(ws + WS_Y); (void)H; (void)QKVG; (void)Y; \
    float* out = KOUT(); (void)out;
    if (IN(0)) {
        PHASE_PTRS();
        transpose_weights(KIN(5), KIN(4), (bf16_t*)(ws + WS_WIN), NIN, DEPTH, (LAS float*)lds);
        transpose_weights(KIN(6), nullptr, (bf16_t*)(ws + WS_WOUT), D, DEPTH, (LAS float*)lds);
        rope_table((float*)(ws + WS_COS), (float*)(ws + WS_SIN));
        norm_phase(KIN(0), KIN(1) - (size_t)MP * D, KIN(4), (bf16_t*)(ws + WS_XB), nullptr, nullptr, (float*)(ws + CTL_SSQ), 2);
        GRID_BAR();
    }
    for (int l = 0; l < DEPTH; ++l) {
        const int pb = 1 + 4 * l;
        const bool even = (l & 1) == 0;
        if (IN(pb)) {
            PHASE_PTRS();
            bf16_t* WIN = (bf16_t*)(ws + WS_WIN); float* COS = (float*)(ws + WS_COS);
            pg8::Gemm g{(bf16_t*)(ws + WS_XB), WIN + (size_t)l * NIN * D}; int bxl = bx; asm volatile("" : "+s"(bxl)); pg8::StaticOrder<MTOT, NIN> S; S.init(G, bxl);
            EpiIn E{QKVG, out, COS, (const float*)(ws + CTL_SSQ) + (size_t)l * MTOT, l};
#ifndef NO_GIN
            pg8::gemm_phase<EpiIn, MTOT, NIN, D>(lds, g, S, E, 0);
#endif
            GRID_BAR();
        }
        if (IN(pb + 1)) {
            PHASE_PTRS();
            bf16_t* CK = (bf16_t*)(ws + WS_CK);
            if (even) {
                const int lane = ltid() & 63;
                const float* lf = KIN(7) + (size_t)(l >> 1) * 4 * 128;
                const float s1 = wave_sum(lf[lane] * lf[128 + lane] + lf[64 + lane] * lf[192 + lane]);
                const float s2 = wave_sum(lf[256 + lane] * lf[384 + lane] + lf[320 + lane] * lf[448 + lane]);
                const float lam_init = (l == 0) ? 0.2f : 0.47071301834358406f;
                const float lam = __int_as_float(__builtin_amdgcn_readfirstlane(__float_as_int(__expf(s1) - __expf(s2) + lam_init)));
                const float* subw = KIN(8) + (size_t)(l >> 1) * 256;
                const bool tab = (G == 256);
                const int nitems = __builtin_amdgcn_readfirstlane(tab ? (int)g_dsched.n[bx >> 3] : (1088 - bx + G - 1) / G);
                for (int k = 0; k < nitems; ++k) {
                    int bh, code;
                    int desc = 0;
                    if (tab) { bh = bx & 7; const int e_ = __builtin_amdgcn_readfirstlane((int)g_dsched.it[bx >> 3][k]); code = e_ & 255; desc = e_ >> 8; }
                    else { const int id = bx + k * G; if (id < 1024) { bh = id & 7; code = id >> 3; } else { bh = (id - 1024) >> 3; code = 128 + ((id - 1024) & 7); } }
                    const bool pr = code < 128;
                    const int x = code, s = bh * 8 + (code - 128);
                    const int b = bh >> 2, h = pr ? (bh & 3) : (s & 3), sb = s >> 2;
                    const size_t row0 = pr ? (size_t)b * SEQ + (size_t)x * 128 : (size_t)MP + (size_t)sb * DSEQ;
                    const size_t krow = pr ? (size_t)b * SEQ : row0;
                    const bf16_t* knew = QKVG + krow * NIN + 1024 + h * 256;
                    const size_t coff = ((size_t)(l * DBATCH + sb) * PAST) * D + h * 256;
                    att::DItem it;
                    it.q = QKVG + row0 * NIN + h * 256;
                    it.kv.k1 = (const char*)knew; it.kv.vd1 = 2048u; it.kv.stride1 = NIN * 2;
                    it.kv.k0 = pr ? (const char*)knew : (const char*)(CK + coff); it.kv.vd0 = pr ? 2048u : (unsigned)(WS_CV - WS_CK);
                    it.kv.stride0 = pr ? NIN * 2 : D * 2; it.kv.nsplit = pr ? (1 << 30) : PAST / 64;
                    it.nt_lo = pr ? 2 * x + 1 : PAST / 64 + 1; it.nt_hi = pr ? 2 * x + 2 : 0;
                    it.o = H + row0 * D + h * 256;
                    it.kf = pr ? nullptr : KIN(2) + coff; it.vf = pr ? nullptr : KIN(3) + coff; it.desc = pr ? desc : 0;
#ifndef NO_DIFF
                    att::diff_item(it, lds, lam, l >> 1, subw);
#endif
                }
            } else {
                for (int id = bx; id < 1088; id += G) {
                    const bool pr = id < 1024;
                    const int bh = id & 7, x = id >> 3, s = id - 1024;
                    const int b = bh >> 2, h = pr ? (bh & 3) : (s & 3), sb = s >> 2;
                    const size_t row0 = pr ? (size_t)b * SEQ + (size_t)x * 128 : (size_t)MP + (size_t)sb * DSEQ;
                    const size_t krow = pr ? (size_t)b * SEQ : row0;
                    const bf16_t* knew = QKVG + krow * NIN + 1024 + h * 256;
                    const size_t coff = ((size_t)(l * DBATCH + sb) * PAST) * D + h * 256;
                    att::SItem it;
                    it.q = QKVG + row0 * NIN + h * 256;
                    it.kv.k1 = (const char*)knew; it.kv.vd1 = 2048u; it.kv.stride1 = NIN * 2;
                    it.kv.k0 = pr ? (const char*)knew : (const char*)(CK + coff); it.kv.vd0 = pr ? 2048u : (unsigned)(WS_CV - WS_CK);
                    it.kv.stride0 = pr ? NIN * 2 : D * 2; it.kv.nsplit = pr ? (1 << 30) : PAST / 64;
                    it.P0 = pr ? x * 128 : PAST; it.nrows = pr ? 128 : DSEQ; it.jstart = pr ? 2 * x + 1 : PAST / 64;
                    it.kf = pr ? nullptr : KIN(2) + coff; it.vf = pr ? nullptr : KIN(3) + coff;
                    it.o = H + row0 * D + h * 256;
#ifndef NO_SB
                    att::sb_item(it, lds);
#endif
                }
            }
            GRID_BAR();
        }
        if (IN(pb + 2)) {
            PHASE_PTRS();
            bf16_t* WOUT = (bf16_t*)(ws + WS_WOUT);
            pg8::Gemm g{H, WOUT + (size_t)l * D * D}; int bxl = bx; asm volatile("" : "+s"(bxl)); pg8::StaticOrder<MTOT, D> S; S.init(G, bxl);
            const bool lastl = l == DEPTH - 1;
            EpiOut E{l == 0 ? KIN(0) : nullptr, l == 0 ? KIN(1) - (size_t)MP * D : nullptr, (bf16_t*)(ws + WS_XB), lastl ? nullptr : (float*)(ws + CTL_SSQ) + (size_t)(l + 1) * MTOT};
#ifndef NO_GOUT
            pg8::gemm_phase<EpiOut, MTOT, D, D>(lds, g, S, E, 0);
#endif
            GRID_BAR();
        }
        if (IN(pb + 3)) {
            PHASE_PTRS();
            if (l == DEPTH - 1) final_norm((const bf16_t*)(ws + WS_XB), KIN(9), out + OY_P, out + OY_S - (size_t)MP * D);
        }
    }
#undef IN
#undef GRID_BAR
}

extern "C" void kernel_launch(void* const* d_in, const int* in_sizes, int n_in, void* d_out, int out_size, void* d_ws, size_t ws_size, hipStream_t stream) {
    static int grid = 0;
    if (grid == 0) {
        if (n_in != 10 || (size_t)out_size != O_END || ws_size < WS_END) { fprintf(stderr, "kernel_launch: unexpected shapes (n_in %d out %d ws %zu, want 10 / %zu / >= %zu)\n", n_in, out_size, ws_size, (size_t)O_END, (size_t)WS_END); grid = -1; return; }
        int dev = 0, cus = 0, per_cu = 0;
        if (hipGetDevice(&dev) != hipSuccess || hipDeviceGetAttribute(&cus, hipDeviceAttributeMultiprocessorCount, dev) != hipSuccess) { grid = -1; return; }
        if (hipFuncSetAttribute((const void*)fwd, hipFuncAttributeMaxDynamicSharedMemorySize, LDS_BYTES) != hipSuccess) { fprintf(stderr, "kernel_launch: hipFuncSetAttribute failed\n"); grid = -1; return; }
        if (hipOccupancyMaxActiveBlocksPerMultiprocessor(&per_cu, (const void*)fwd, NTHR, LDS_BYTES) != hipSuccess || per_cu < 1) { fprintf(stderr, "kernel_launch: occupancy query says %d blocks per CU\n", per_cu); }
        (void)hipGetLastError();
        grid = cus;
    }
    if (grid < 0) return;
    (void)hipMemsetAsync((char*)d_ws + WS_CTL, 0, CTL_BYTES, stream);
    const float* in[10];
    for (int i = 0; i < 10; ++i) in[i] = (const float*)d_in[i];
#if MK_PER_PHASE
    for (int p = 0; p < 17; ++p) hipLaunchKernelGGL(fwd, dim3(grid), dim3(NTHR), LDS_BYTES, stream, in[0], in[1], in[2], in[3], in[4], in[5], in[6], in[7], in[8], in[9], (float*)d_out, (unsigned char*)d_ws, p, p + 1);
#else
    hipLaunchKernelGGL(fwd, dim3(grid), dim3(NTHR), LDS_BYTES, stream, in[0], in[1], in[2], in[3], in[4], in[5], in[6], in[7], in[8], in[9], (float*)d_out, (unsigned char*)d_ws, 0, 17);
#endif
}
```
